# Optimizing an MI355X kernel written in HIP

```python
import math
import jax, jax.numpy as jnp
from jax import lax
import numpy as np

D_MODEL = 1024
BATCH = 16
SEQ = 2048
DEPTH = 2

D_FF = 4 * D_MODEL
EPS = 1e-6
NEG_BIG = -1e30
M_HEADS = 4
M_DIM = D_MODEL // 16
M_WIDTH = M_HEADS * M_DIM
M_CONV = 4
M_CHUNK = 128
A_HEADS = 4
A_DIM = D_MODEL // 16
A_WIDTH = A_HEADS * 2 * A_DIM
ROT_DIM = A_DIM // 4
ROPE_THETA = 500000.0
Q_BLOCK = 128
H_HEADS = 4
H_DK = D_MODEL // 16
H_DV = D_MODEL // 16
H_WIDTH = H_HEADS * H_DV
H_CHUNK = 64
D_MIX = M_WIDTH + A_WIDTH + H_WIDTH
M_COLS = 4 * M_WIDTH + 2 * M_HEADS
A_COLS = 3 * A_WIDTH
H_COLS = 4 * H_WIDTH
D_IN = M_COLS + A_COLS + H_COLS

kernel_name = 'hymba_style_mlstm_diffattn_hgrn2'


def rmsnorm(x, g):
    xf = x.astype(jnp.float32)
    y = xf * lax.rsqrt(jnp.mean(xf * xf, axis=-1, keepdims=True) + EPS)
    return (y * g.astype(jnp.float32)).astype(x.dtype)


def causal_dwconv(x, w):
    K = w.shape[0]
    T = x.shape[1]
    xp = jnp.pad(x, ((0, 0), (K - 1, 0), (0, 0)))
    out = xp[:, 0:T] * w[0]
    for j in range(1, K):
        out = out + xp[:, j:j + T] * w[j]
    return out


def partial_rope(x, pos):
    half = ROT_DIM // 2
    inv = ROPE_THETA ** (-jnp.arange(half, dtype=jnp.float32) / half)
    ang = pos.astype(jnp.float32)[:, None] * inv[None, :]
    cos = jnp.cos(ang)[:, None, :]
    sin = jnp.sin(ang)[:, None, :]
    x1 = x[..., :half]
    x2 = x[..., half:ROT_DIM]
    r1 = x1 * cos - x2 * sin
    r2 = x2 * cos + x1 * sin
    return jnp.concatenate([r1, r2, x[..., ROT_DIM:]], axis=-1)


def to_chunks(a, L):
    B, H, T = a.shape[:3]
    a = a.reshape((B, H, T // L, L) + a.shape[3:])
    return jnp.moveaxis(a, 2, 0)


def from_chunks(a):
    a = jnp.moveaxis(a, 0, 2)
    B, H, NC, L = a.shape[:4]
    return a.reshape((B, H, NC * L) + a.shape[4:])


def mlstm_chunkwise(q, k, v, i_pre, f_pre):
    B, H, T, d = q.shape
    L = M_CHUNK
    k = k * (d ** -0.5)
    logf = jax.nn.log_sigmoid(f_pre)
    xs = (to_chunks(q, L), to_chunks(k, L), to_chunks(v, L), to_chunks(i_pre, L), to_chunks(logf, L))
    causal = jnp.tril(jnp.ones((L, L), dtype=bool))

    def step(carry, xs_c):
        C, n, m = carry
        qb, kb, vb, ib, fb = xs_c
        b = jnp.cumsum(fb, axis=-1)
        D = b[..., :, None] - b[..., None, :] + ib[..., None, :]
        D = jnp.where(causal, D, NEG_BIG)
        inter = b + m[..., None]
        m_t = jnp.maximum(jnp.max(D, axis=-1), inter)
        S = jnp.einsum('bhtd,bhsd->bhts', qb, kb) * jnp.exp(D - m_t[..., None])
        scale = jnp.exp(inter - m_t)
        num = jnp.einsum('bhts,bhsv->bhtv', S, vb) + scale[..., None] * jnp.einsum('bhvk,bhtk->bhtv', C, qb)
        den = jnp.sum(S, axis=-1) + scale * jnp.einsum('bhk,bhtk->bht', n, qb)
        h = num / jnp.maximum(jnp.abs(den), jnp.exp(-m_t))[..., None]
        bL = b[..., -1]
        g = bL[..., None] - b + ib
        m_new = jnp.maximum(bL + m, jnp.max(g, axis=-1))
        w_s = jnp.exp(g - m_new[..., None])
        decay = jnp.exp(bL + m - m_new)
        C_new = decay[..., None, None] * C + jnp.einsum('bhs,bhsv,bhsk->bhvk', w_s, vb, kb)
        n_new = decay[..., None] * n + jnp.einsum('bhs,bhsk->bhk', w_s, kb)
        return (C_new, n_new, m_new), h

    init = (jnp.zeros((B, H, d, d), jnp.float32), jnp.zeros((B, H, d), jnp.float32), jnp.zeros((B, H), jnp.float32))
    _, h = lax.scan(step, init, xs)
    return from_chunks(h)


def mlstm_mixer(q_pre, k_pre, v, o_pre, i_pre, f_pre, conv_w, gate_b, norm_g):
    B, T, _ = q_pre.shape
    f32 = jnp.float32
    qk = jax.nn.silu(causal_dwconv(jnp.concatenate([q_pre, k_pre], axis=-1).astype(f32), conv_w.astype(f32)))
    q, k = qk[..., :M_WIDTH], qk[..., M_WIDTH:]
    heads = lambda a: a.reshape(B, T, M_HEADS, M_DIM).transpose(0, 2, 1, 3)
    gb = gate_b.astype(f32)
    i_g = (i_pre.astype(f32) + gb[0]).transpose(0, 2, 1)
    f_g = (f_pre.astype(f32) + gb[1]).transpose(0, 2, 1)
    h = mlstm_chunkwise(heads(q), heads(k), heads(v.astype(f32)), i_g, f_g)
    h = rmsnorm(h.transpose(0, 2, 1, 3), norm_g)
    h = jax.nn.sigmoid(o_pre.astype(f32)).reshape(B, T, M_HEADS, M_DIM) * h
    return h.reshape(B, T, M_WIDTH)


def diff_attention(q, k, v, qn_g, kn_g, lam_vec, subln_g, lambda_init):
    B, T, _ = q.shape
    f32 = jnp.float32
    pos = jnp.arange(T)
    q = rmsnorm(q.astype(f32).reshape(B, T, A_HEADS, 2, A_DIM), qn_g)
    k = rmsnorm(k.astype(f32).reshape(B, T, A_HEADS, 2, A_DIM), kn_g)
    q = partial_rope(q.reshape(B, T, A_HEADS * 2, A_DIM), pos).reshape(B, T, A_HEADS, 2, A_DIM)
    k = partial_rope(k.reshape(B, T, A_HEADS * 2, A_DIM), pos).reshape(B, T, A_HEADS, 2, A_DIM)
    q = q * (A_DIM ** -0.5)
    v = v.astype(f32).reshape(B, T, A_HEADS, 2 * A_DIM).transpose(0, 2, 1, 3)
    kt = k.transpose(0, 2, 3, 1, 4)
    lv = lam_vec.astype(f32)
    lam = jnp.exp(jnp.sum(lv[0] * lv[1])) - jnp.exp(jnp.sum(lv[2] * lv[3])) + lambda_init
    NB = T // Q_BLOCK
    qb = q.reshape(B, NB, Q_BLOCK, A_HEADS, 2, A_DIM).transpose(1, 0, 3, 4, 2, 5)
    kpos = jnp.arange(T)

    def block(args):
        qi, bi = args
        s = jnp.einsum('bhcqd,bhckd->bhcqk', qi, kt)
        qpos = bi * Q_BLOCK + jnp.arange(Q_BLOCK)
        mask = qpos[:, None] >= kpos[None, :]
        p = jax.nn.softmax(jnp.where(mask, s, NEG_BIG), axis=-1)
        a = p[:, :, 0] - lam * p[:, :, 1]
        return jnp.einsum('bhqk,bhkv->bhqv', a, v)

    o = lax.map(block, (qb, jnp.arange(NB)))
    o = o.transpose(1, 0, 3, 2, 4).reshape(B, T, A_HEADS, 2 * A_DIM)
    o = rmsnorm(o, subln_g) * (1.0 - lambda_init)
    return o.reshape(B, T, A_WIDTH)


def hgrn2_chunkwise(q, logf, k, v):
    B, H, T, dk = q.shape
    dv = v.shape[-1]
    L = H_CHUNK
    xs = (to_chunks(q, L), to_chunks(logf, L), to_chunks(k, L), to_chunks(v, L))
    causal = jnp.tril(jnp.ones((L, L), dtype=bool))[..., None]

    def step(S, xs_c):
        qb, gb, kb, vb = xs_c
        Bc = jnp.cumsum(gb, axis=-2)
        diff = Bc[..., :, None, :] - Bc[..., None, :, :]
        decay = jnp.exp(jnp.where(causal, diff, NEG_BIG))
        A = jnp.einsum('bhtk,bhsk,bhtsk->bhts', qb, kb, decay)
        o = jnp.einsum('bhts,bhsv->bhtv', A, vb) + jnp.einsum('bhtk,bhkv->bhtv', qb * jnp.exp(Bc), S)
        BL = Bc[..., -1:, :]
        S_new = jnp.exp(BL[..., 0, :])[..., None] * S + jnp.einsum('bhsk,bhsv->bhkv', kb * jnp.exp(BL - Bc), vb)
        return S_new, o

    _, o = lax.scan(step, jnp.zeros((B, H, dk, dv), jnp.float32), xs)
    return from_chunks(o)


def hgrn2_mixer(q_pre, f_pre, i_pre, g_pre, lb, norm_g):
    B, T, _ = q_pre.shape
    f32 = jnp.float32
    heads = lambda a, dd: a.astype(f32).reshape(B, T, H_HEADS, dd).transpose(0, 2, 1, 3)
    q = jax.nn.silu(heads(q_pre, H_DK))
    fp = heads(f_pre, H_DK)
    lbh = lb.reshape(H_HEADS, 1, H_DK)
    f = lbh + (1.0 - lbh) * jax.nn.sigmoid(fp)
    logf = jnp.log(f)
    k = (1.0 - lbh) * jax.nn.sigmoid(-fp)
    v = heads(i_pre, H_DV)
    o = hgrn2_chunkwise(q, logf, k, v).transpose(0, 2, 1, 3)
    o = rmsnorm(o, norm_g) * jax.nn.silu(g_pre.astype(f32)).reshape(B, T, H_HEADS, H_DV)
    return o.reshape(B, T, H_WIDTH)


def setup_inputs(seed: int = 0) -> dict:
    key = jax.random.key(seed)
    ks = jax.random.split(key, 20)
    f32 = jnp.float32
    nrm = lambda k, shp, s: jax.random.normal(k, shp, f32) * s
    f_bias = jnp.broadcast_to(jnp.linspace(3.0, 6.0, M_HEADS, dtype=f32), (DEPTH, M_HEADS))
    mlstm_gate_b = jnp.stack([nrm(ks[4], (DEPTH, M_HEADS), 0.1), f_bias + nrm(ks[5], (DEPTH, M_HEADS), 0.1)], axis=1)
    return {
        'x': jax.random.normal(ks[0], (BATCH, SEQ, D_MODEL), f32),
        'norm1_g': 1.0 + nrm(ks[1], (DEPTH, D_MODEL), 0.02),
        'w_in': nrm(ks[2], (DEPTH, D_MODEL, D_IN), D_MODEL ** -0.5),
        'mlstm_conv_w': nrm(ks[3], (DEPTH, M_CONV, 2 * M_WIDTH), M_CONV ** -0.5),
        'mlstm_gate_b': mlstm_gate_b,
        'mlstm_norm_g': 1.0 + nrm(ks[6], (DEPTH, M_DIM), 0.02),
        'diff_q_norm_g': 1.0 + nrm(ks[7], (DEPTH, A_DIM), 0.02),
        'diff_k_norm_g': 1.0 + nrm(ks[8], (DEPTH, A_DIM), 0.02),
        'diff_lambda': nrm(ks[9], (DEPTH, 4, A_DIM), 0.1),
        'diff_subln_g': 1.0 + nrm(ks[10], (DEPTH, 2 * A_DIM), 0.02),
        'hgrn_lb_param': nrm(ks[11], (DEPTH, H_HEADS * H_DK), 1.0),
        'hgrn_norm_g': 1.0 + nrm(ks[12], (DEPTH, H_DV), 0.02),
        'w_out': nrm(ks[13], (DEPTH, D_MIX, D_MODEL), D_MIX ** -0.5),
        'norm2_g': 1.0 + nrm(ks[14], (DEPTH, D_MODEL), 0.02),
        'w_up': nrm(ks[15], (DEPTH, D_MODEL, D_FF), D_MODEL ** -0.5),
        'w_down': nrm(ks[16], (DEPTH, D_FF, D_MODEL), D_FF ** -0.5),
    }


def reference(x, norm1_g, w_in, mlstm_conv_w, mlstm_gate_b, mlstm_norm_g, diff_q_norm_g, diff_k_norm_g,
              diff_lambda, diff_subln_g, hgrn_lb_param, hgrn_norm_g, w_out, norm2_g, w_up, w_down):
    sm = jax.nn.softmax(hgrn_lb_param.astype(jnp.float32), axis=0)
    lower_bounds = jnp.cumsum(sm, axis=0) - sm[0]
    split_at = np.cumsum([M_WIDTH, M_WIDTH, M_WIDTH, M_WIDTH, M_HEADS, M_HEADS,
                          A_WIDTH, A_WIDTH, A_WIDTH,
                          H_WIDTH, H_WIDTH, H_WIDTH])
    for l in range(DEPTH):
        lambda_init = 0.8 - 0.6 * math.exp(-0.3 * l)
        h = rmsnorm(x, norm1_g[l])
        u = jnp.einsum('btd,de->bte', h, w_in[l])
        (mq, mk, mv, mo, mi, mf, aq, ak, av, hq, hf, hi, hg) = jnp.split(u, split_at, axis=-1)
        y_m = mlstm_mixer(mq, mk, mv, mo, mi, mf, mlstm_conv_w[l], mlstm_gate_b[l], mlstm_norm_g[l])
        y_a = diff_attention(aq, ak, av, diff_q_norm_g[l], diff_k_norm_g[l], diff_lambda[l], diff_subln_g[l], lambda_init)
        y_h = hgrn2_mixer(hq, hf, hi, hg, lower_bounds[l], hgrn_norm_g[l])
        mix = jnp.concatenate([y_m, y_a, y_h], axis=-1).astype(x.dtype)
        x = x + jnp.einsum('bte,ed->btd', mix, w_out[l])
        h2 = rmsnorm(x, norm2_g[l])
        a = jnp.square(jax.nn.relu(jnp.einsum('btd,df->btf', h2, w_up[l])))
        x = x + jnp.einsum('btf,fd->btd', a, w_down[l])
    return x
```

```cpp
#include <hip/hip_runtime.h>
#include <hip/hip_cooperative_groups.h>
#include <cstdio>
#include <cstdint>
namespace cg = cooperative_groups;
namespace pg8 {
#define PG8_LAS __attribute__((address_space(3)))
typedef unsigned short bf16_t;
typedef short bf16x8 __attribute__((ext_vector_type(8)));
typedef float f32x4 __attribute__((ext_vector_type(4)));
typedef unsigned u32x4 __attribute__((ext_vector_type(4)));
constexpr int BM = 256, BK = 64, HALF = 128, HTB = HALF * BK * 2  , STAGE_BYTES = 8 * HTB, NXCD = 8, WGM = 8;

__host__ __device__ __forceinline__ int lds_byte(int r, int c) { const int st = (r >> 4) * 2 + (c >> 5), rr = r & 15, cc = c & 31, ob = rr * 64 + cc * 2; return st * 1024 + (ob ^ (((ob >> 9) & 1) << 5)); }
__host__ __device__ __forceinline__ void stage_rc(int b, int& R, int& C) { const int st = b / 1024, sb = b % 1024, swz = sb ^ (((sb >> 9) & 1) << 5); R = (st >> 1) * 16 + swz / 64; C = (st & 1) * 32 + (swz % 64) / 2; }
__host__ __device__ __forceinline__ int perm32(int rho) { const int n = rho >> 4, i = rho & 15; return 8 * (i >> 2) + 4 * n + (i & 3); }

struct Unit { int pm, pn; };
struct Gemm { const bf16_t* A; const bf16_t* Bt; int M, N, K; };

struct StaticOrder {
    int nM, nN, nwg, G, c;
    __host__ __device__ void init(int M, int N, int G_, int c_) { nM = M / BM; nN = N / BM; nwg = nM * nN; G = G_; c = c_; }
    __host__ __device__ bool next(int i, Unit& u) const {
        const long L = (long)i * G + c; if (L >= nwg) return false;
        int wgid = (int)L; { const int q = nwg / NXCD, r = nwg % NXCD, xcd = wgid % NXCD, off = wgid / NXCD; wgid = (xcd < r ? xcd * (q + 1) : r * (q + 1) + (xcd - r) * q) + off; }
        const int nig = WGM * nN, gid = wgid / nig, fm = gid * WGM, gsz = (nM - fm) < WGM ? (nM - fm) : WGM;
        u.pm = fm + ((wgid % nig) % gsz); u.pn = (wgid % nig) / gsz; return true;
    }
    __device__ __forceinline__ void a_ready(const Unit&) const {}
    __device__ __forceinline__ void done(const Unit&) const {}
};

__device__ __forceinline__ unsigned cvt_pk_bf16(float lo, float hi) { unsigned r; asm volatile("v_cvt_pk_bf16_f32 %0, %1, %2" : "=v"(r) : "v"(lo), "v"(hi)); return r; }
typedef float f32x2 __attribute__((ext_vector_type(2)));
template <int ACT> struct EpiScaleBf16 {
    static constexpr bool PERM = true, AFTER_DRAIN = false;
    bf16_t* O; int ldc; const float* ss;
    __device__ __forceinline__ void operator()(const f32x4 (&acc)[2][2][4][2], const Unit& u, int wr, int wc, int fr, int fq) const {
        const int row0 = u.pm * BM + wr * 64 + fr; const int col0 = u.pn * BM + wc * 32 + 8 * fq;
#pragma unroll
        for (int ai = 0; ai < 2; ++ai)
#pragma unroll
            for (int m = 0; m < 4; ++m) { const int row = row0 + ai * HALF + m * 16; const float s = __builtin_amdgcn_rsqf(ss[row] * (1.0f / 1024.0f) + 1e-6f); bf16_t* rowp = O + (size_t)row * ldc + col0;
#pragma unroll
                for (int bj = 0; bj < 2; ++bj) { f32x4 v0 = acc[ai][bj][m][0] * s, v1 = acc[ai][bj][m][1] * s;
                    if (ACT == 1) {
#pragma unroll
                        for (int e = 0; e < 4; ++e) { float a = v0[e] > 0.f ? v0[e] : 0.f; v0[e] = a * a; float b = v1[e] > 0.f ? v1[e] : 0.f; v1[e] = b * b; } }
                    u32x4 w; w.x = cvt_pk_bf16(v0[0], v0[1]); w.y = cvt_pk_bf16(v0[2], v0[3]); w.z = cvt_pk_bf16(v1[0], v1[1]); w.w = cvt_pk_bf16(v1[2], v1[3]);
                    *(u32x4*)(rowp + bj * HALF) = w; }
                if (m & 1) asm volatile("" ::: "memory"); }
    }
};
struct EpiResidBf {
    static constexpr bool PERM = true, AFTER_DRAIN = false;
    bf16_t* xb; float* out; int ldc; float* ssn; int last;
    __device__ __forceinline__ void operator()(const f32x4 (&acc)[2][2][4][2], const Unit& u, int wr, int wc, int fr, int fq) const {
        const int row0 = u.pm * BM + wr * 64 + fr; const int col0 = u.pn * BM + wc * 32 + 8 * fq;
#pragma unroll
        for (int ai = 0; ai < 2; ++ai) {
            u32x4 bs[4][2];
#pragma unroll
            for (int m = 0; m < 4; ++m) { const size_t off = (size_t)(row0 + ai * HALF + m * 16) * ldc + col0;
#pragma unroll
                for (int bj = 0; bj < 2; ++bj) bs[m][bj] = *(const u32x4*)(xb + off + bj * HALF); }
#pragma unroll
            for (int m = 0; m < 4; ++m) { const int row = row0 + ai * HALF + m * 16; const size_t off = (size_t)row * ldc + col0; float sq = 0.f;
#pragma unroll
                for (int bj = 0; bj < 2; ++bj) { const size_t idx = off + bj * HALF; const u32x4 b = bs[m][bj];
                    const f32x4 b0 = {__builtin_bit_cast(float, b.x << 16), __builtin_bit_cast(float, b.x & 0xffff0000u), __builtin_bit_cast(float, b.y << 16), __builtin_bit_cast(float, b.y & 0xffff0000u)};
                    const f32x4 b1 = {__builtin_bit_cast(float, b.z << 16), __builtin_bit_cast(float, b.z & 0xffff0000u), __builtin_bit_cast(float, b.w << 16), __builtin_bit_cast(float, b.w & 0xffff0000u)};
                    const f32x4 v0 = b0 + acc[ai][bj][m][0], v1 = b1 + acc[ai][bj][m][1];
                    if (last) { *(f32x4*)(out + idx) = v0; *(f32x4*)(out + idx + 4) = v1; }
                    else {
                        sq += (v0[0] * v0[0] + v0[1] * v0[1]) + (v0[2] * v0[2] + v0[3] * v0[3]) + (v1[0] * v1[0] + v1[1] * v1[1]) + (v1[2] * v1[2] + v1[3] * v1[3]);
                        u32x4 w; w.x = cvt_pk_bf16(v0[0], v0[1]); w.y = cvt_pk_bf16(v0[2], v0[3]); w.z = cvt_pk_bf16(v1[0], v1[1]); w.w = cvt_pk_bf16(v1[2], v1[3]);
                        *(u32x4*)(xb + idx) = w; } }
                if (!last) { sq += __shfl_xor(sq, 16); sq += __shfl_xor(sq, 32); if (fq == 0) atomicAdd(ssn + row, sq); } }
            asm volatile("" ::: "memory"); }
    }
};
struct EpiIn {
    static constexpr bool PERM = true, AFTER_DRAIN = false;
    bf16_t* O; int ldc; const float* ss; const float* RP; const float* qg; const float* kg;
    __device__ __forceinline__ void operator()(f32x4 (&acc)[2][2][4][2], const Unit& u, int wr, int wc, int fr, int fq) const {
        const int row0 = u.pm * BM + wr * 64 + fr; const int col0 = u.pn * BM + wc * 64 + 8 * fq;
        const bool qk = (u.pn >= 4) && (u.pn < 8);
        if (qk) {
            const bool isq = u.pn < 6; const float* gn = (isq ? qg : kg) + 8 * fq;
            float gv[2][8];
#pragma unroll
            for (int bj = 0; bj < 2; ++bj)
#pragma unroll
                for (int j = 0; j < 8; ++j) gv[bj][j] = gn[32 * bj + j];
            const float qs = isq ? 0.125f * 1.4426950408889634f : 1.0f;
            f32x4 rpn[4] = {{1.f, 0.f, 1.f, 0.f}, {1.f, 0.f, 1.f, 0.f}, {1.f, 0.f, 1.f, 0.f}, {1.f, 0.f, 1.f, 0.f}};
            const bool roper = fq < 2;
            if (roper) { const float* rp = RP + (size_t)(row0 & 2047) * 16; rpn[0] = *(const f32x4*)rp; rpn[1] = *(const f32x4*)(rp + 4); rpn[2] = *(const f32x4*)(rp + 8); rpn[3] = *(const f32x4*)(rp + 12); }
#pragma unroll
            for (int g = 0; g < 8; ++g) { const int ai = g >> 2, m = g & 3; const int row = row0 + ai * HALF + m * 16; bf16_t* rowp = O + (size_t)row * ldc + col0;
                const f32x4 a = rpn[0], b = rpn[1], c = rpn[2], d = rpn[3];
                if (g < 7 && roper) { const int rown = row0 + ((g + 1) >> 2) * HALF + ((g + 1) & 3) * 16; const float* rp = RP + (size_t)(rown & 2047) * 16;
                    rpn[0] = *(const f32x4*)rp; rpn[1] = *(const f32x4*)(rp + 4); rpn[2] = *(const f32x4*)(rp + 8); rpn[3] = *(const f32x4*)(rp + 12); }
                f32x4 c0 = (f32x4){a.x, a.z, b.x, b.z}, s0 = (f32x4){a.y, a.w, b.y, b.w}, c1 = (f32x4){c.x, c.z, d.x, d.z}, s1 = (f32x4){c.y, c.w, d.y, d.w};
                if (fq == 0) { s0 = -s0; s1 = -s1; }
                const float s = __builtin_amdgcn_rsqf(ss[row] * (1.0f / 1024.0f) + 1e-6f);
                f32x4 v[2][2]; float p = 0.f;
#pragma unroll
                for (int bj = 0; bj < 2; ++bj) { v[bj][0] = acc[ai][bj][m][0] * s; v[bj][1] = acc[ai][bj][m][1] * s;
                    p += (v[bj][0][0] * v[bj][0][0] + v[bj][0][1] * v[bj][0][1]) + (v[bj][0][2] * v[bj][0][2] + v[bj][0][3] * v[bj][0][3]) + (v[bj][1][0] * v[bj][1][0] + v[bj][1][1] * v[bj][1][1]) + (v[bj][1][2] * v[bj][1][2] + v[bj][1][3] * v[bj][1][3]); }
                p += __shfl_xor(p, 16); p += __shfl_xor(p, 32);
                const float rg = __builtin_amdgcn_rsqf(p * (1.0f / 64.0f) + 1e-6f);
#pragma unroll
                for (int bj = 0; bj < 2; ++bj) {
                    f32x4 v0 = v[bj][0] * rg, v1 = v[bj][1] * rg;
                    v0 = v0 * (f32x4){gv[bj][0], gv[bj][1], gv[bj][2], gv[bj][3]}; v1 = v1 * (f32x4){gv[bj][4], gv[bj][5], gv[bj][6], gv[bj][7]};
                    if (bj == 0) {
                        f32x4 o0, o1;
#pragma unroll
                        for (int e = 0; e < 4; ++e) { o0[e] = __shfl_xor(v0[e], 16); o1[e] = __shfl_xor(v1[e], 16); }
                        v0 = v0 * c0 + o0 * s0; v1 = v1 * c1 + o1 * s1; }
                    v0 = v0 * qs; v1 = v1 * qs;
                    u32x4 w; w.x = cvt_pk_bf16(v0[0], v0[1]); w.y = cvt_pk_bf16(v0[2], v0[3]); w.z = cvt_pk_bf16(v1[0], v1[1]); w.w = cvt_pk_bf16(v1[2], v1[3]);
                    *(u32x4*)(rowp + bj * 32) = w; }
                asm volatile("" ::: "memory"); }
        } else {
#pragma unroll
            for (int ai = 0; ai < 2; ++ai)
#pragma unroll
                for (int m = 0; m < 4; ++m) { const int row = row0 + ai * HALF + m * 16; const float s = __builtin_amdgcn_rsqf(ss[row] * (1.0f / 1024.0f) + 1e-6f); bf16_t* rowp = O + (size_t)row * ldc + col0;
#pragma unroll
                    for (int bj = 0; bj < 2; ++bj) { const f32x4 v0 = acc[ai][bj][m][0] * s, v1 = acc[ai][bj][m][1] * s;
                        u32x4 w; w.x = cvt_pk_bf16(v0[0], v0[1]); w.y = cvt_pk_bf16(v0[2], v0[3]); w.z = cvt_pk_bf16(v1[0], v1[1]); w.w = cvt_pk_bf16(v1[2], v1[3]);
                        *(u32x4*)(rowp + bj * 32) = w; }
                    if (m & 1) asm volatile("" ::: "memory"); }
        }
    }
};
template <class Epi, class Sched, bool ALIGN_EPI = false, bool SP2 = false>
__device__ __forceinline__ void gemm_phase(PG8_LAS unsigned char* lds, const Gemm g, const Sched& S, const Epi& E, int tid_in) {
    int tid_l = tid_in; asm volatile("" : "+v"(tid_l));
    const int tid = tid_l, wid = __builtin_amdgcn_readfirstlane(tid >> 6), lane = tid & 63, wr = wid >> 2, wc = wid & 3, fr = lane & 15, fq = lane >> 4;
    const int K = g.K, nt = K / BK;
    unsigned voffA[2], voffB[2];
#pragma unroll
    for (int i = 0; i < 2; ++i) { int R, C; stage_rc(tid * 16 + i * 8192, R, C); const int Rb = Epi::PERM ? ((R & ~31) + perm32(R & 31)) : R;
        voffA[i] = (unsigned)(R * K + C) * 2u; voffB[i] = (unsigned)(Rb * K + C) * 2u; }
    const size_t kstep = (size_t)(BK * 2);
    const size_t hstep = (size_t)HALF * K * 2;
    const size_t tstep = 2 * hstep;
    const unsigned ldsw = (unsigned)wid * 1024u;
    const int aoff = lds_byte(wr * 64 + fr, fq * 8), boff = lds_byte(wc * 32 + fr, fq * 8);
#define PG8_SA(b, h) (((b) * 2 + (h)) * HTB)
#define PG8_SB(b, h) ((4 + (b) * 2 + (h)) * HTB)
#define PG8_STAGE(bufoff, gbase, voff) do { _Pragma("unroll") for (int _i = 0; _i < 2; ++_i) \
        __builtin_amdgcn_global_load_lds((const unsigned*)((const char*)(gbase) + (voff)[_i]), (PG8_LAS unsigned*)(lds + (bufoff) + ldsw + _i * 8192), 16, 0, 0); } while (0)
#define PG8_LDA(dst, b, h) do { _Pragma("unroll") for (int m = 0; m < 4; ++m) _Pragma("unroll") for (int k = 0; k < 2; ++k) dst[m][k] = *(const PG8_LAS bf16x8*)(lds + PG8_SA(b, h) + aoff + m * 2048 + k * 1024); } while (0)
#define PG8_LDB(dst, b, h) do { _Pragma("unroll") for (int n = 0; n < 2; ++n) _Pragma("unroll") for (int k = 0; k < 2; ++k) dst[n][k] = *(const PG8_LAS bf16x8*)(lds + PG8_SB(b, h) + boff + n * 2048 + k * 1024); } while (0)
#define PG8_MMA(ai, bj, At, Bt) do { __builtin_amdgcn_s_setprio(1); _Pragma("unroll") for (int m = 0; m < 4; ++m) _Pragma("unroll") for (int n = 0; n < 2; ++n) _Pragma("unroll") for (int k = 0; k < 2; ++k) \
        acc[ai][bj][m][n] = __builtin_amdgcn_mfma_f32_16x16x32_bf16(Bt[n][k], At[m][k], acc[ai][bj][m][n], 0, 0, 0); __builtin_amdgcn_s_setprio(0); } while (0)
#define PG8_WAIT_V(n) asm volatile("s_waitcnt vmcnt(" #n ")" ::: "memory")
#define PG8_WAIT_L(n) asm volatile("s_waitcnt lgkmcnt(" #n ")" ::: "memory")
#define PG8_BAR __builtin_amdgcn_s_barrier()
#define PG8_SCHED __builtin_amdgcn_sched_barrier(0)
    Unit cur, nxt; int ui = 0;
    if (!S.next(0, cur)) return;
    f32x4 acc[2][2][4][2];
#pragma unroll
    for (int a = 0; a < 2; ++a)
#pragma unroll
        for (int b = 0; b < 2; ++b)
#pragma unroll
            for (int m = 0; m < 4; ++m)
#pragma unroll
                for (int n = 0; n < 2; ++n) acc[a][b][m][n] = (f32x4){0.f, 0.f, 0.f, 0.f};
    bf16x8 At[4][2], B0[2][2], B1[2][2];
    const char* cA = (const char*)g.A + (size_t)cur.pm * tstep; const char* cB = (const char*)g.Bt + (size_t)cur.pn * tstep;
    S.a_ready(cur);
    if constexpr (SP2) {
        PG8_STAGE(PG8_SB(0, 0), cB, voffB); PG8_STAGE(PG8_SB(0, 1), cB + hstep, voffB); PG8_STAGE(PG8_SA(0, 0), cA, voffA); PG8_STAGE(PG8_SA(0, 1), cA + hstep, voffA);
        if (wr == 1) PG8_BAR;
        PG8_WAIT_V(2); PG8_BAR;
        PG8_STAGE(PG8_SB(1, 0), cB + kstep, voffB); PG8_STAGE(PG8_SA(1, 0), cA + kstep, voffA); PG8_STAGE(PG8_SB(1, 1), cB + hstep + kstep, voffB);
        PG8_WAIT_V(6); PG8_BAR;
    } else {
        PG8_STAGE(PG8_SB(0, 0), cB, voffB); PG8_STAGE(PG8_SA(0, 0), cA, voffA); PG8_STAGE(PG8_SB(0, 1), cB + hstep, voffB); PG8_STAGE(PG8_SA(0, 1), cA + hstep, voffA);
        if (wr == 1) PG8_BAR;
        PG8_WAIT_V(4); PG8_BAR;
        PG8_STAGE(PG8_SB(1, 0), cB + kstep, voffB); PG8_STAGE(PG8_SA(1, 0), cA + kstep, voffA); PG8_STAGE(PG8_SB(1, 1), cB + hstep + kstep, voffB);
        PG8_WAIT_V(6); PG8_BAR;
    }
    for (;;) {
        const bool has_next = S.next(ui + 1, nxt);
        const char* nA = has_next ? (const char*)g.A + (size_t)nxt.pm * tstep : cA; const char* nB = has_next ? (const char*)g.Bt + (size_t)nxt.pn * tstep : cB;
        for (int t = 0; t < nt; t += 2) {
            const bool last = (t == nt - 2);
            const char* a1 = cA + (size_t)(t + 1) * kstep;
            const char* a2 = last ? nA : cA + (size_t)(t + 2) * kstep; const char* b2 = last ? nB : cB + (size_t)(t + 2) * kstep;
            const char* a3 = a2 + kstep; const char* b3 = b2 + kstep;
            if (last && has_next) S.a_ready(nxt);
            if constexpr (SP2) {
            PG8_LDB(B0, 0, 0); PG8_LDB(B1, 0, 1); PG8_SCHED; PG8_LDA(At, 0, 0); PG8_STAGE(PG8_SA(1, 1), a1 + hstep, voffA);
            PG8_WAIT_V(8); PG8_WAIT_L(0); PG8_BAR; PG8_MMA(0, 0, At, B0); PG8_MMA(0, 1, At, B1); PG8_BAR; PG8_SCHED;
            PG8_LDA(At, 0, 1); PG8_STAGE(PG8_SB(0, 0), b2, voffB); PG8_STAGE(PG8_SB(0, 1), b2 + hstep, voffB); PG8_STAGE(PG8_SA(0, 0), a2, voffA);
            PG8_WAIT_V(8); PG8_WAIT_L(0); PG8_BAR; PG8_MMA(1, 0, At, B0); PG8_MMA(1, 1, At, B1); PG8_BAR; PG8_SCHED;
            PG8_LDB(B0, 1, 0); PG8_LDB(B1, 1, 1); PG8_SCHED; PG8_LDA(At, 1, 0); PG8_STAGE(PG8_SA(0, 1), a2 + hstep, voffA);
            PG8_WAIT_V(8); PG8_WAIT_L(0); PG8_BAR; PG8_MMA(0, 0, At, B0); PG8_MMA(0, 1, At, B1); PG8_BAR; PG8_SCHED;
            PG8_LDA(At, 1, 1); PG8_STAGE(PG8_SB(1, 0), b3, voffB); PG8_STAGE(PG8_SB(1, 1), b3 + hstep, voffB); PG8_STAGE(PG8_SA(1, 0), a3, voffA);
            PG8_WAIT_V(8); PG8_WAIT_L(0); PG8_BAR; PG8_MMA(1, 0, At, B0); PG8_MMA(1, 1, At, B1); PG8_BAR; PG8_SCHED;
            } else {
            PG8_LDB(B0, 0, 0); PG8_SCHED; PG8_LDA(At, 0, 0); PG8_STAGE(PG8_SA(1, 1), a1 + hstep, voffA);
            PG8_WAIT_L(8); PG8_BAR; PG8_WAIT_L(0); PG8_MMA(0, 0, At, B0); PG8_BAR; PG8_SCHED;
            PG8_LDB(B1, 0, 1); PG8_STAGE(PG8_SB(0, 0), b2, voffB);
            PG8_BAR; PG8_WAIT_L(0); PG8_MMA(0, 1, At, B1); PG8_BAR;
            PG8_LDA(At, 0, 1); PG8_STAGE(PG8_SA(0, 0), a2, voffA);
            PG8_BAR; PG8_WAIT_L(0); PG8_MMA(1, 0, At, B0); PG8_BAR; PG8_SCHED;
            PG8_STAGE(PG8_SB(0, 1), b2 + hstep, voffB);
            PG8_WAIT_V(6); PG8_BAR; PG8_MMA(1, 1, At, B1); PG8_BAR;
            PG8_LDB(B0, 1, 0); PG8_SCHED; PG8_LDA(At, 1, 0); PG8_STAGE(PG8_SA(0, 1), a2 + hstep, voffA);
            PG8_WAIT_L(8); PG8_BAR; PG8_WAIT_L(0); PG8_MMA(0, 0, At, B0); PG8_BAR; PG8_SCHED;
            PG8_LDB(B1, 1, 1); PG8_STAGE(PG8_SB(1, 0), b3, voffB);
            PG8_BAR; PG8_WAIT_L(0); PG8_MMA(0, 1, At, B1); PG8_BAR;
            PG8_LDA(At, 1, 1); PG8_STAGE(PG8_SA(1, 0), a3, voffA);
            PG8_BAR; PG8_WAIT_L(0); PG8_MMA(1, 0, At, B0); PG8_BAR; PG8_SCHED;
            PG8_STAGE(PG8_SB(1, 1), b3 + hstep, voffB);
            PG8_WAIT_V(6); PG8_BAR; PG8_MMA(1, 1, At, B1); PG8_BAR;
            }
        }
        if constexpr (ALIGN_EPI) { if (wr == 0) PG8_BAR; }
        if constexpr (!Epi::AFTER_DRAIN) { E(acc, cur, wr, wc, fr, fq); S.done(cur); }
        if (!has_next) break;
#pragma unroll
        for (int a = 0; a < 2; ++a)
#pragma unroll
            for (int b = 0; b < 2; ++b)
#pragma unroll
                for (int m = 0; m < 4; ++m)
#pragma unroll
                    for (int n = 0; n < 2; ++n) acc[a][b][m][n] = (f32x4){0.f, 0.f, 0.f, 0.f};
        cur = nxt; cA = nA; cB = nB; ++ui;
        if constexpr (ALIGN_EPI) { if (wr == 1) PG8_BAR; }
    }
    PG8_WAIT_V(0);
    if constexpr (!ALIGN_EPI) { if (wr == 0) PG8_BAR; }
    PG8_BAR;
    if constexpr (Epi::AFTER_DRAIN) { E.fused(acc, cur, wr, wc, fr, fq, lds, wid, lane); S.done(cur); }
#undef PG8_SA
#undef PG8_SB
#undef PG8_STAGE
#undef PG8_LDA
#undef PG8_LDB
#undef PG8_MMA
#undef PG8_WAIT_V
#undef PG8_WAIT_L
#undef PG8_BAR
#undef PG8_SCHED
}
}
#define DI __device__ __forceinline__
typedef unsigned short bf16_t;
typedef short bf16x8 __attribute__((ext_vector_type(8)));
typedef short s16x4 __attribute__((ext_vector_type(4)));
typedef float f32x16 __attribute__((ext_vector_type(16)));
typedef float f32x4 __attribute__((ext_vector_type(4)));
typedef unsigned u32x4 __attribute__((ext_vector_type(4)));
typedef unsigned u32x2 __attribute__((ext_vector_type(2)));
constexpr int NB = 16, T = 2048, D = 1024, M = NB * T, FF = 4096, DEPTH = 2;
constexpr int NU = 3584;
constexpr int DIN = 3592;
constexpr float EPS = 1e-6f;
constexpr int U_MQ = 0, U_MK = 256, U_MV = 512, U_MO = 768, U_AQ = 1024, U_AK = 1536, U_AV = 2048, U_HQ = 2560, U_HF = 2816, U_HI = 3072, U_HG = 3328;
constexpr float LOG2E = 1.4426950408889634f;
constexpr size_t MiB = 1u << 20;
constexpr size_t WS_CTL = 0, CTL_BYTES = 65536;
constexpr size_t WS_ROPE = 1 * MiB;
constexpr size_t WS_SS = 2 * MiB;
constexpr size_t WS_GATE = 3 * MiB;
constexpr size_t WS_WG = 4 * MiB;
constexpr size_t WS_LB = 4 * MiB + 512 * 1024;
constexpr size_t WS_PAR = 4 * MiB + 768 * 1024;
constexpr int PAR_GB = 0, PAR_MN = 64, PAR_QN = 192, PAR_KN = 320, PAR_LAM = 448, PAR_SUB = 960, PAR_HN = 1216, PAR_CW = 1344, PAR_N = 5440, PAR_LAMV = 5440;
constexpr size_t WS_W = 5 * MiB;
constexpr size_t W_LAYER = 25 * MiB, W_IN = 0, W_OUT = 7 * MiB, W_UP = 9 * MiB, W_DN = 17 * MiB;
constexpr size_t WS_XB = 56 * MiB;
constexpr size_t WS_U = 120 * MiB;
constexpr size_t WS_MIX = 344 * MiB;
constexpr size_t WS_H = 120 * MiB;
constexpr size_t WS_END = 408 * MiB;
constexpr int LDS_BYTES = 147456;
constexpr int NTHREADS = 512;

DI unsigned f2bf(float f) { unsigned u = __builtin_bit_cast(unsigned, f); return (u + 0x7fffu + ((u >> 16) & 1u)) >> 16; }
DI float bf2f(unsigned short b) { return __builtin_bit_cast(float, (unsigned)b << 16); }
typedef float f32x2_t __attribute__((ext_vector_type(2))); typedef __bf16 bf16x2_t __attribute__((ext_vector_type(2)));
DI unsigned cvtpk(float lo, float hi) { f32x2_t v = {lo, hi}; bf16x2_t b = __builtin_convertvector(v, bf16x2_t); return __builtin_bit_cast(unsigned, b); }
DI bf16x8 pack8(const f32x16& x, int s) { u32x4 p; p.x = cvtpk(x[8 * s], x[8 * s + 1]); p.y = cvtpk(x[8 * s + 2], x[8 * s + 3]); p.z = cvtpk(x[8 * s + 4], x[8 * s + 5]); p.w = cvtpk(x[8 * s + 6], x[8 * s + 7]); return __builtin_bit_cast(bf16x8, p); }
DI int crow(int reg, int h) { return (reg & 3) + 8 * (reg >> 2) + 4 * h; }
#define MFMA32(a, b, c) __builtin_amdgcn_mfma_f32_32x32x16_bf16((a), (b), (c), 0, 0, 0)
DI bf16x8 ld8(const bf16_t* p) { return *(const bf16x8*)p; }
DI bf16x8 ld_perm(const bf16_t* p, int h) { const s16x4 lo = *(const s16x4*)(p + 4 * h), hi = *(const s16x4*)(p + 8 + 4 * h); return __builtin_shufflevector(lo, hi, 0, 1, 2, 3, 4, 5, 6, 7); }
DI void lds_barrier() { asm volatile("s_waitcnt lgkmcnt(0)" ::: "memory"); __builtin_amdgcn_s_barrier(); asm volatile("" ::: "memory"); }
DI float sigmoidf_(float x) { return __builtin_amdgcn_rcpf(1.f + __expf(-x)); }
DI float wave_sum(float v) {
#pragma unroll
    for (int o = 1; o < 64; o <<= 1) v += __shfl_xor(v, o);
    return v;
}
DI void unpack8(const u32x4& w, float* f) {
    f[0] = __builtin_bit_cast(float, w.x << 16); f[1] = __builtin_bit_cast(float, w.x & 0xffff0000u);
    f[2] = __builtin_bit_cast(float, w.y << 16); f[3] = __builtin_bit_cast(float, w.y & 0xffff0000u);
    f[4] = __builtin_bit_cast(float, w.z << 16); f[5] = __builtin_bit_cast(float, w.z & 0xffff0000u);
    f[6] = __builtin_bit_cast(float, w.w << 16); f[7] = __builtin_bit_cast(float, w.w & 0xffff0000u);
}
DI u32x4 pack8f(const float* f) { u32x4 w; w.x = cvtpk(f[0], f[1]); w.y = cvtpk(f[2], f[3]); w.z = cvtpk(f[4], f[5]); w.w = cvtpk(f[6], f[7]); return w; }

struct Params {
    const float* x; const float* norm1_g; const float* w_in; const float* conv_w; const float* gate_b; const float* mnorm_g;
    const float* qn_g; const float* kn_g; const float* lam; const float* subln_g; const float* lb_param; const float* hnorm_g;
    const float* w_out; const float* norm2_g; const float* w_up; const float* w_down;
    float* out; unsigned char* ws; int ph_lo, ph_hi;
};

struct TDesc { const float* W; bf16_t* WT; const float* g; int K, Nsrc, skip_from, skip, k0, n0, wide; };
DI TDesc tt_decode(const Params& P, int it) {
    constexpr int T_IN = (D / 64) * (NU / 256), T_OUT = (D / 64) * (D / 256), T_UP = (D / 64) * (FF / 256), T_DN = (FF / 64) * (D / 256), T_L = T_IN + T_OUT + T_UP + T_DN;
    const int l = it / T_L; int r = it % T_L; unsigned char* wb = P.ws + WS_W + (size_t)l * W_LAYER; TDesc d;
    if (r < T_IN) { d.W = P.w_in + (size_t)l * D * DIN; d.WT = (bf16_t*)(wb + W_IN); d.g = P.norm1_g + l * D; d.K = D; d.Nsrc = DIN; d.skip_from = 1024; d.skip = 8; d.k0 = (r / (NU / 256)) * 64; d.n0 = (r % (NU / 256)) * 256; d.wide = 1; return d; } r -= T_IN;
    if (r < T_OUT) { d.W = P.w_out + (size_t)l * D * D; d.WT = (bf16_t*)(wb + W_OUT); d.g = nullptr; d.K = D; d.Nsrc = D; d.skip_from = 1 << 30; d.skip = 0; d.k0 = (r / (D / 256)) * 64; d.n0 = (r % (D / 256)) * 256; d.wide = 0; return d; } r -= T_OUT;
    if (r < T_UP) { d.W = P.w_up + (size_t)l * D * FF; d.WT = (bf16_t*)(wb + W_UP); d.g = P.norm2_g + l * D; d.K = D; d.Nsrc = FF; d.skip_from = 1 << 30; d.skip = 0; d.k0 = (r / (FF / 256)) * 64; d.n0 = (r % (FF / 256)) * 256; d.wide = 0; return d; } r -= T_UP;
    d.W = P.w_down + (size_t)l * FF * D; d.WT = (bf16_t*)(wb + W_DN); d.g = nullptr; d.K = FF; d.Nsrc = D; d.skip_from = 1 << 30; d.skip = 0; d.k0 = (r / (D / 256)) * 64; d.n0 = (r % (D / 256)) * 256; d.wide = 0; return d;
}
DI void tt_load(const TDesc& d, float (&v)[32], int tid) {
    const int c = tid & 255, rr = tid >> 8;
    const int cl = d.wide ? (64 * ((c >> 5) & 3) + 32 * (c >> 7) + (c & 31)) : c;
    const int nsrc = d.n0 + cl + ((d.n0 + cl) >= d.skip_from ? d.skip : 0);
#pragma unroll
    for (int i = 0; i < 32; ++i) v[i] = d.W[(size_t)(d.k0 + rr + 2 * i) * d.Nsrc + nsrc];
}
DI void tt_finish(const TDesc& d, float (&v)[32], float* scr, int tid) {
    const int c = tid & 255, rr = tid >> 8;
    if (d.g) {
#pragma unroll
        for (int i = 0; i < 32; ++i) v[i] *= d.g[d.k0 + rr + 2 * i]; }
#pragma unroll
    for (int i = 0; i < 32; ++i) scr[c * 65 + rr + 2 * i] = v[i];
    __syncthreads();
#pragma unroll
    for (int i = 0; i < 4; ++i) { const int id = tid + 512 * i, n = id >> 3, kc = (id & 7) * 8;
        float f[8];
#pragma unroll
        for (int j = 0; j < 8; ++j) f[j] = scr[n * 65 + kc + j];
        *(u32x4*)(d.WT + (size_t)(d.n0 + n) * d.K + d.k0 + kc) = pack8f(f); }
    __syncthreads();
}
DI void p0_prep(const Params& P, unsigned char* lds, int tid_in) {
    float* scr = (float*)lds; int tid = tid_in; asm volatile("" : "+v"(tid));
    constexpr int T_IN = (D / 64) * (NU / 256), T_OUT = (D / 64) * (D / 256), T_UP = (D / 64) * (FF / 256), T_DN = (FF / 64) * (D / 256), T_L = T_IN + T_OUT + T_UP + T_DN;
    {
        int it = blockIdx.x;
        if (it < DEPTH * T_L) {
            TDesc d = tt_decode(P, it); float v[32]; tt_load(d, v, tid);
            for (;;) {
                const int itn = it + gridDim.x; const bool more = itn < DEPTH * T_L;
                TDesc dn = d; float vn[32];
                if (more) { dn = tt_decode(P, itn); tt_load(dn, vn, tid); }
                tt_finish(d, v, scr, tid);
                if (!more) break;
                d = dn; it = itn;
#pragma unroll
                for (int i = 0; i < 32; ++i) v[i] = vn[i];
            }
        }
    }
    const int gt = blockIdx.x * NTHREADS + tid, NT_ = gridDim.x * NTHREADS;
    float* WG = (float*)(P.ws + WS_WG);
    for (int i = gt; i < DEPTH * 8 * D; i += NT_) { const int l = i / (8 * D), j = (i / D) % 8, k = i % D; WG[i] = P.norm1_g[l * D + k] * P.w_in[(size_t)l * D * DIN + (size_t)k * DIN + 1024 + j]; }
    { float* PR = (float*)(P.ws + WS_PAR);
      for (int i = gt; i < PAR_N; i += NT_) { float v;
        if (i < PAR_MN) v = (i < 16) ? P.gate_b[i] : 0.f; else if (i < PAR_QN) v = P.mnorm_g[i - PAR_MN]; else if (i < PAR_KN) v = P.qn_g[i - PAR_QN]; else if (i < PAR_LAM) v = P.kn_g[i - PAR_KN];
        else if (i < PAR_SUB) v = P.lam[i - PAR_LAM]; else if (i < PAR_HN) v = P.subln_g[i - PAR_SUB]; else if (i < PAR_CW) v = P.hnorm_g[i - PAR_HN]; else v = P.conv_w[i - PAR_CW];
        PR[i] = v; } }
    { float* SS = (float*)(P.ws + WS_SS); for (int i = gt; i < 3 * M; i += NT_) SS[M + i] = 0.f; }
    if (blockIdx.x == 0 && tid < 64) {
        for (int l = 0; l < DEPTH; ++l) { const float* lv = P.lam + l * 256; const float s1 = wave_sum(lv[tid] * lv[64 + tid]), s2 = wave_sum(lv[128 + tid] * lv[192 + tid]);
            const float lam_init = (l == 0) ? 0.2f : 0.35550906759096926f;
            if (tid == 0) ((float*)(P.ws + WS_PAR))[PAR_LAMV + l] = __expf(s1) - __expf(s2) + lam_init; } }
    float* LB = (float*)(P.ws + WS_LB);
    for (int i = gt; i < 256; i += NT_) { const float a = P.lb_param[i], b = P.lb_param[256 + i]; const float mx = fmaxf(a, b); const float ea = __expf(a - mx), eb = __expf(b - mx); LB[i] = 0.f; LB[256 + i] = eb / (ea + eb); }
    float* RP = (float*)(P.ws + WS_ROPE);
    for (int i = gt; i < T * 8; i += NT_) {
        const int pos = i >> 3, fi = i & 7;
        const float inv = fi == 0 ? 1.0f : fi == 1 ? 0.1939227432012558f : fi == 2 ? 0.03760603070259094f : fi == 3 ? 0.007292664609849453f : fi == 4 ? 0.0014142135623842478f
                        : fi == 5 ? 0.00027424818836152554f : fi == 6 ? 5.318296098266728e-05f : 1.0313386155758053e-05f;
        const float af = (float)pos * inv; const double xx = (double)af;
        const double kq = __builtin_rint(xx * 0.63661977236758134308); const double r = (xx - kq * 1.57079632679489661923) ; const double r2 = r * r;
        const double sn = r * (1.0 + r2 * (-1.0 / 6 + r2 * (1.0 / 120 + r2 * (-1.0 / 5040 + r2 * (1.0 / 362880 + r2 * (-1.0 / 39916800 + r2 * (1.0 / 6227020800.0)))))));
        const double cs = 1.0 + r2 * (-0.5 + r2 * (1.0 / 24 + r2 * (-1.0 / 720 + r2 * (1.0 / 40320 + r2 * (-1.0 / 3628800 + r2 * (1.0 / 479001600.0))))));
        const int qd = ((int)kq) & 3;
        const double s_ = (qd == 0) ? sn : (qd == 1) ? cs : (qd == 2) ? -sn : -cs;
        const double c_ = (qd == 0) ? cs : (qd == 1) ? -sn : (qd == 2) ? -cs : sn;
        RP[2 * i] = (float)c_; RP[2 * i + 1] = (float)s_;
    }
}

DI void row_prep(const float* X, bf16_t* XB, float* SS, const float* w_in0, const float* g1, const float* gb, float* GATE, float* wlds, int tid) {
    for (int k = tid; k < D; k += NTHREADS) { const f32x4 a = *(const f32x4*)(w_in0 + (size_t)k * DIN + 1024), c = *(const f32x4*)(w_in0 + (size_t)k * DIN + 1028); const float g = g1[k];
        wlds[0 * D + k] = a.x * g; wlds[1 * D + k] = a.y * g; wlds[2 * D + k] = a.z * g; wlds[3 * D + k] = a.w * g; wlds[4 * D + k] = c.x * g; wlds[5 * D + k] = c.y * g; wlds[6 * D + k] = c.z * g; wlds[7 * D + k] = c.w * g; }
    __syncthreads();
    const int lane = tid & 63, wv = tid >> 6; const int gw = blockIdx.x * 8 + wv, NGW = gridDim.x * 8;
    for (int m = gw; m < M; m += 2 * NGW) {
        const int m2 = m + NGW;
        const f32x4* xr = (const f32x4*)(X + (size_t)m * D) + lane; const f32x4* xr2 = (const f32x4*)(X + (size_t)(m2 < M ? m2 : m) * D) + lane;
        f32x4 v[4], v2[4]; float s = 0.f, s2 = 0.f;
#pragma unroll
        for (int j = 0; j < 4; ++j) { v[j] = xr[64 * j]; v2[j] = xr2[64 * j]; }
#pragma unroll
        for (int j = 0; j < 4; ++j) { s += (v[j].x * v[j].x + v[j].y * v[j].y) + (v[j].z * v[j].z + v[j].w * v[j].w); s2 += (v2[j].x * v2[j].x + v2[j].y * v2[j].y) + (v2[j].z * v2[j].z + v2[j].w * v2[j].w); }
        s = wave_sum(s); s2 = wave_sum(s2);
        u32x2* o8 = (u32x2*)(XB + (size_t)m * D) + lane;
#pragma unroll
        for (int j = 0; j < 4; ++j) { u32x2 w; w.x = cvtpk(v[j].x, v[j].y); w.y = cvtpk(v[j].z, v[j].w); o8[64 * j] = w; }
        if (lane == 0) SS[m] = s;
        if (m2 < M) { u32x2* o82 = (u32x2*)(XB + (size_t)m2 * D) + lane;
#pragma unroll
            for (int j = 0; j < 4; ++j) { u32x2 w; w.x = cvtpk(v2[j].x, v2[j].y); w.y = cvtpk(v2[j].z, v2[j].w); o82[64 * j] = w; }
            if (lane == 0) SS[m2] = s2; }
        float g1v = 0.f, g2v = 0.f;
#pragma unroll
        for (int g = 0; g < 8; ++g) { float a = 0.f, a2 = 0.f;
#pragma unroll
            for (int j = 0; j < 4; ++j) { const f32x4 w = *(const f32x4*)(wlds + g * D + 256 * j + 4 * lane);
                a += (v[j].x * w.x + v[j].y * w.y) + (v[j].z * w.z + v[j].w * w.w); a2 += (v2[j].x * w.x + v2[j].y * w.y) + (v2[j].z * w.z + v2[j].w * w.w); }
            a = wave_sum(a); a2 = wave_sum(a2); g1v = (lane == g) ? a : g1v; g2v = (lane == g) ? a2 : g2v; }
        if (lane < 8) { GATE[(size_t)m * 8 + lane] = g1v * __builtin_amdgcn_rsqf(s * (1.0f / D) + EPS) + gb[lane];
            if (m2 < M) GATE[(size_t)m2 * 8 + lane] = g2v * __builtin_amdgcn_rsqf(s2 * (1.0f / D) + EPS) + gb[lane]; }
    }
    __syncthreads();
}
DI void gates_prep(const bf16_t* XB, const float* SS, const float* WG, const float* gb, float* GATE, float* wlds, int tid) {
    bf16_t* wb = (bf16_t*)wlds;
    for (int i = tid; i < 8 * D / 8; i += NTHREADS) { const f32x4 a = ((const f32x4*)WG)[2 * i], c = ((const f32x4*)WG)[2 * i + 1]; const float t8[8] = {a.x, a.y, a.z, a.w, c.x, c.y, c.z, c.w}; ((u32x4*)wb)[i] = pack8f(t8); }
    __syncthreads();
    const int lane = tid & 63, r = lane & 31, h = lane >> 5, wv = tid >> 6;
    for (int blk = blockIdx.x * 8 + wv; blk < M / 32; blk += gridDim.x * 8) {
        const int m0 = blk * 32;
        const bf16_t* xr = XB + (size_t)(m0 + r) * D + 8 * h;
        f32x16 acc;
#pragma unroll
        for (int e = 0; e < 16; ++e) acc[e] = 0.f;
#pragma unroll 8
        for (int ks = 0; ks < D / 16; ++ks) {
            const bf16x8 a = *(const bf16x8*)(xr + 16 * ks);
            bf16x8 bfr = {0, 0, 0, 0, 0, 0, 0, 0};
            if (r < 8) bfr = *(const bf16x8*)(wb + r * D + 16 * ks + 8 * h);
            acc = MFMA32(a, bfr, acc);
        }
        if (r < 8) { const float bias = gb[r];
#pragma unroll
            for (int e = 0; e < 16; ++e) { const int m = m0 + crow(e, h); GATE[(size_t)m * 8 + r] = acc[e] * __builtin_amdgcn_rsqf(SS[m] * (1.0f / D) + EPS) + bias; } }
    }
    __syncthreads();
}

DI void attn_qk_prep(bf16_t* U, const float* qg, const float* kg, const float* RP, int tid, bf16_t* DST = nullptr) {
    const int sub = tid & 7, grp = (tid >> 3) & 15, rib = tid >> 7;
    float gg[8];
#pragma unroll
    for (int j = 0; j < 8; ++j) gg[j] = ((grp < 8) ? qg : kg)[sub * 8 + j];
    for (int m0 = blockIdx.x * 32 + rib; m0 < M; m0 += gridDim.x * 32) {
        u32x4 w[8];
#pragma unroll
        for (int i = 0; i < 8; ++i) w[i] = *(const u32x4*)(U + (size_t)(m0 + 4 * i) * NU + U_AQ + grp * 64 + sub * 8);
#pragma unroll
        for (int i = 0; i < 8; ++i) {
            const int m = m0 + 4 * i; float f[8]; unpack8(w[i], f);
            float ss = 0.f;
#pragma unroll
            for (int j = 0; j < 8; ++j) ss += f[j] * f[j];
            ss += __shfl_xor(ss, 1); ss += __shfl_xor(ss, 2); ss += __shfl_xor(ss, 4);
            const float rstd = __builtin_amdgcn_rsqf(ss * (1.f / 64) + EPS);
#pragma unroll
            for (int j = 0; j < 8; ++j) f[j] = f[j] * rstd * gg[j];
            const int pos = m & (T - 1);
            float oth[8];
#pragma unroll
            for (int j = 0; j < 8; ++j) oth[j] = __shfl_xor(f[j], 1);
            if (sub < 2) {
                const float* rp = RP + (size_t)pos * 16;
#pragma unroll
                for (int j = 0; j < 8; ++j) { const float c = rp[2 * j], s = rp[2 * j + 1]; f[j] = (sub == 0) ? (f[j] * c - oth[j] * s) : (f[j] * c + oth[j] * s); }
            }
            if (grp < 8) {
#pragma unroll
                for (int j = 0; j < 8; ++j) f[j] *= 0.125f * LOG2E;
            }
            if (DST) *(u32x4*)(DST + (size_t)m * D + grp * 64 + sub * 8) = pack8f(f); else *(u32x4*)(U + (size_t)m * NU + U_AQ + grp * 64 + sub * 8) = pack8f(f);
        }
    }
}
typedef short v4i16_t __attribute__((ext_vector_type(4)));
typedef __attribute__((address_space(3))) const unsigned char* lds_cp;
DI s16x4 tr_rd(lds_cp p) { return __builtin_bit_cast(s16x4, __builtin_amdgcn_ds_read_tr16_b64_v4i16((__attribute__((address_space(3))) v4i16_t*)p)); }
template <bool PERMK> DI bf16x8 tr_frag(lds_cp img, int pitchB, int k0, int m0, int lane) {
    const int h = lane >> 5, q = (lane & 15) >> 2, p = lane & 3, blk = (lane >> 4) & 1;
    const int kl = PERMK ? (k0 + 4 * h + q) : (k0 + 8 * h + q), kh = PERMK ? (kl + 8) : (kl + 4);
    const int cb = (m0 + 16 * blk + 4 * p) * 2;
    const s16x4 lo = tr_rd(img + kl * pitchB + cb), hi = tr_rd(img + kh * pitchB + cb);
    return __builtin_shufflevector(lo, hi, 0, 1, 2, 3, 4, 5, 6, 7);
}
constexpr int AT_KB = 18432, AT_VB = 18432, AT_BUF = AT_KB + AT_VB;
constexpr int AT_OX = 0, AT_OS = 2 * AT_BUF;
DI void attn_unit(const bf16_t* U, bf16_t* MIX, int b, int hd, int qb, float lam, float osc, const float* subg, unsigned char* lds, int tid_in) {
    int tid = tid_in; asm volatile("" : "+v"(tid));
    const int lane = tid & 63, r = lane & 31, h = lane >> 5, w = __builtin_amdgcn_readfirstlane(tid >> 6), c = w >> 2, wq = w & 3;
    float* OX = (float*)(lds + AT_OX); bf16_t* OS = (bf16_t*)(lds + AT_OS);
    const lds_cp lds3 = (lds_cp)lds;
    const size_t rowbase = (size_t)b * T; const int q0 = qb * 128; const int NT = 2 * qb + 2;
    bf16x8 qf[4];
    { const bf16_t* qp = U + (rowbase + q0 + 32 * wq + r) * NU + U_AQ + hd * 128 + c * 64 + 8 * h;
#pragma unroll
      for (int ks = 0; ks < 4; ++ks) qf[ks] = ld8(qp + 16 * ks); }
    u32x4 kreg[2], vreg[2];
#define AT_PREFETCH(kt) do { _Pragma("unroll") for (int i_ = 0; i_ < 2; ++i_) { const int id_ = tid + 512 * i_, key_ = id_ >> 4, ch_ = id_ & 15; \
        const bf16_t* rp_ = U + (rowbase + 64 * (kt) + key_) * NU + hd * 128 + ch_ * 8; kreg[i_] = *(const u32x4*)(rp_ + U_AK); vreg[i_] = *(const u32x4*)(rp_ + U_AV); } } while (0)
#define AT_STORE(buf) do { unsigned char* kb_ = lds + (buf) * AT_BUF; _Pragma("unroll") for (int i_ = 0; i_ < 2; ++i_) { const int id_ = tid + 512 * i_, key_ = id_ >> 4, ch_ = id_ & 15; \
        *(u32x4*)(kb_ + (((ch_ >> 3) * 64 + key_) * 72 + (ch_ & 7) * 8) * 2) = kreg[i_]; *(u32x4*)(kb_ + AT_KB + (key_ * 144 + ch_ * 8) * 2) = vreg[i_]; } } while (0)
    AT_PREFETCH(0);
    __syncthreads();
    AT_STORE(0);
    if (NT > 1) AT_PREFETCH(1);
    float m_ref = 0.f, l_run = 0.f; f32x16 o[4]; f32x16 negm;
#pragma unroll
    for (int e = 0; e < 16; ++e) negm[e] = 0.f;
#pragma unroll
    for (int vb = 0; vb < 4; ++vb)
#pragma unroll
        for (int e = 0; e < 16; ++e) o[vb][e] = 0.f;
    const int qpos = q0 + 32 * wq + r;
    __syncthreads();
    for (int kt = 0; kt < NT; ++kt) {
        const int cur = kt & 1;
        if (kt + 1 < NT) { AT_STORE(cur ^ 1); if (kt + 2 < NT) AT_PREFETCH(kt + 2); }
        const bf16_t* KS = (const bf16_t*)(lds + cur * AT_BUF); const lds_cp VS = lds3 + cur * AT_BUF + AT_KB;
        if (kt != NT - 1 || wq >= 2) {
        f32x16 st[2];
        {
            bf16x8 kf[2][4];
#pragma unroll
            for (int nb = 0; nb < 2; ++nb)
#pragma unroll
                for (int ks = 0; ks < 4; ++ks) kf[nb][ks] = ld8(KS + (c * 64 + 32 * nb + r) * 72 + 16 * ks + 8 * h);
            __builtin_amdgcn_sched_barrier(0);
            __builtin_amdgcn_s_setprio(1);
#pragma unroll
            for (int nb = 0; nb < 2; ++nb) {
                st[nb] = MFMA32(kf[nb][0], qf[0], negm);
#pragma unroll
                for (int ks = 1; ks < 4; ++ks) st[nb] = MFMA32(kf[nb][ks], qf[ks], st[nb]); }
            __builtin_amdgcn_s_setprio(0);
        }
        if (kt >= 2 * qb) {
            asm volatile("" ::: "memory");
#pragma unroll
            for (int nb = 0; nb < 2; ++nb)
#pragma unroll
                for (int e = 0; e < 16; ++e) { const int key = 64 * kt + 32 * nb + crow(e, h); if (key > qpos) st[nb][e] = -1e30f; } }
        float mx = st[0][0];
#pragma unroll
        for (int nb = 0; nb < 2; ++nb)
#pragma unroll
            for (int e = 0; e < 16; ++e) mx = fmaxf(mx, st[nb][e]);
        { const auto rr_ = __builtin_amdgcn_permlane32_swap(__float_as_uint(mx), __float_as_uint(mx), false, false); mx = fmaxf(__uint_as_float(rr_[0]), __uint_as_float(rr_[1])); }
        if (kt == 0 || __any(mx > 8.0f)) {
            const float delta = (kt == 0) ? mx : fmaxf(mx, 0.f); const float alpha = __builtin_amdgcn_exp2f(-delta); m_ref += delta; l_run *= alpha;
#pragma unroll
            for (int nb = 0; nb < 2; ++nb)
#pragma unroll
                for (int e = 0; e < 16; ++e) st[nb][e] -= delta;
#pragma unroll
            for (int e = 0; e < 16; ++e) negm[e] = -m_ref;
#pragma unroll
            for (int vb = 0; vb < 4; ++vb)
#pragma unroll
                for (int e = 0; e < 16; ++e) o[vb][e] *= alpha;
        }
        f32x2_t ps2 = {0.f, 0.f};
#pragma unroll
        for (int e = 0; e < 16; e += 2) { const float p0 = __builtin_amdgcn_exp2f(st[0][e]), p1 = __builtin_amdgcn_exp2f(st[0][e + 1]); st[0][e] = p0; st[0][e + 1] = p1; ps2 += (f32x2_t){p0, p1}; }
        {
            bf16x8 va[8], vn[8];
#pragma unroll
            for (int i = 0; i < 8; ++i) va[i] = tr_frag<true>(VS, 288, 16 * (i >> 2), 32 * (i & 3), lane);
            const bf16x8 pfa = pack8(st[0], 0), pfb = pack8(st[0], 1);
            __builtin_amdgcn_sched_barrier(0);
            __builtin_amdgcn_s_setprio(1);
#pragma unroll
            for (int i = 0; i < 8; ++i) {
                o[i & 3] = MFMA32(va[i], (i < 4) ? pfa : pfb, o[i & 3]);
                vn[i] = tr_frag<true>(VS, 288, 32 + 16 * (i >> 2), 32 * (i & 3), lane);
                { const int e2 = 2 * i; const float p0 = __builtin_amdgcn_exp2f(st[1][e2]), p1 = __builtin_amdgcn_exp2f(st[1][e2 + 1]); st[1][e2] = p0; st[1][e2 + 1] = p1; ps2 += (f32x2_t){p0, p1}; }
                __builtin_amdgcn_sched_barrier(0);
            }
            l_run += ps2.x + ps2.y;
            const bf16x8 pfc = pack8(st[1], 0), pfd = pack8(st[1], 1);
            __builtin_amdgcn_sched_barrier(0);
#pragma unroll
            for (int i = 0; i < 8; ++i) o[i & 3] = MFMA32(vn[i], (i < 4) ? pfc : pfd, o[i & 3]);
            __builtin_amdgcn_s_setprio(0);
        }
        }
        lds_barrier();
    }
#undef AT_PREFETCH
#undef AT_STORE
    const float l_tot = l_run + __shfl_xor(l_run, 32); const float inv_l = __builtin_amdgcn_rcpf(l_tot);
    if (c == 1) {
#pragma unroll
        for (int vb = 0; vb < 4; ++vb)
#pragma unroll
            for (int e = 0; e < 16; ++e) OX[(wq * 32 + r) * 129 + 32 * vb + crow(e, h)] = o[vb][e] * inv_l; }
    __syncthreads();
    if (c == 0) {
        float ss = 0.f;
#pragma unroll
        for (int vb = 0; vb < 4; ++vb)
#pragma unroll
            for (int e = 0; e < 16; ++e) { const float v = o[vb][e] * inv_l - lam * OX[(wq * 32 + r) * 129 + 32 * vb + crow(e, h)]; o[vb][e] = v; ss += v * v; }
        ss += __shfl_xor(ss, 32);
        const float rn = osc * __builtin_amdgcn_rsqf(ss * (1.f / 128) + EPS);
#pragma unroll
        for (int vb = 0; vb < 4; ++vb)
#pragma unroll
            for (int e = 0; e < 16; ++e) { const int v = 32 * vb + crow(e, h); OS[(wq * 32 + r) * 136 + v] = (bf16_t)f2bf(o[vb][e] * rn * subg[v]); }
    }
    __syncthreads();
    if (c == 0) {
#pragma unroll
        for (int i = 0; i < 8; ++i) { const int idx = i * 64 + lane, row = idx >> 4, ch = idx & 15;
            const u32x4 v = *(const u32x4*)(OS + (wq * 32 + row) * 136 + ch * 8);
            *(u32x4*)(MIX + (rowbase + q0 + 32 * wq + row) * D + 256 + hd * 128 + ch * 8) = v; }
    }
}
constexpr int ML_Q = 0, ML_K = 18432, ML_WK = 36864, ML_V = 55296, ML_C = 73728, ML_H = 82944, ML_AR = 116224, ML_N = 118272, ML_CW = 118528, ML_CF = 120576, ML_NG = 137216;
DI float logsigf_(float x) { return fminf(x, 0.f) - __logf(1.f + __expf(-fabsf(x))); }
DI void mlstm_unit(const bf16_t* U, const float* GATE, bf16_t* MIX, const float* convw, const float* ng, int b, int hd, unsigned char* lds, int tid_in) {
    int tid = tid_in; asm volatile("" : "+v"(tid));
    const int lane = tid & 63, r = lane & 31, h = lane >> 5, w = __builtin_amdgcn_readfirstlane(tid >> 6);
    bf16_t* Q = (bf16_t*)(lds + ML_Q); bf16_t* K = (bf16_t*)(lds + ML_K); bf16_t* WK = (bf16_t*)(lds + ML_WK); bf16_t* VV = (bf16_t*)(lds + ML_V);
    bf16_t* CL = (bf16_t*)(lds + ML_C); float* H = (float*)(lds + ML_H); float* AR = (float*)(lds + ML_AR); float* NV = (float*)(lds + ML_N); float* CW = (float*)(lds + ML_CW);
    float* rowt = AR; float* colt = AR + 128; float* scl = AR + 256; float* dfl = AR + 384;
    const lds_cp lds3 = (lds_cp)lds;
    const size_t rowbase = (size_t)b * T;
    __syncthreads();
    { const int j = tid >> 7, ch = tid & 127; CW[j * 128 + ch] = convw[j * 512 + (ch < 64 ? hd * 64 + ch : 256 + hd * 64 + (ch - 64))]; }
    float* NG = (float*)(lds + ML_NG);
    if (tid < 64) { NV[tid] = 0.f; NG[tid] = ng[tid]; }
    for (int i = tid; i < 64 * 72; i += NTHREADS) CL[i] = 0;
    float* CF = (float*)(lds + ML_CF);
    for (int i = tid; i < 64 * 65; i += NTHREADS) CF[i] = 0.f;
    float mprev = 0.f;
    const int cch = tid & 15, rblk = tid >> 4;
    const int ccol = (cch < 8) ? (U_MQ + hd * 64 + cch * 8) : (U_MK + hd * 64 + (cch - 8) * 8);
    const int ft = tid >> 2, fv0 = (tid & 3) * 16;
    u32x4 ncr[7]; float ngt[4];
#define ML_PREFETCH(c_) do { const int t0_ = 128 * (c_); \
        _Pragma("unroll") for (int j_ = 0; j_ < 7; ++j_) { const int tt_ = t0_ + 4 * rblk - 3 + j_; ncr[j_] = (tt_ >= 0) ? *(const u32x4*)(U + (rowbase + tt_) * NU + ccol) : (u32x4){0u, 0u, 0u, 0u}; } \
        { const float* gp_ = GATE + (rowbase + t0_ + 2 * lane) * 8; ngt[0] = gp_[hd]; ngt[1] = gp_[4 + hd]; ngt[2] = gp_[8 + hd]; ngt[3] = gp_[12 + hd]; } } while (0)
    ML_PREFETCH(0);
    for (int c = 0; c < T / 128; ++c) {
        const int t0 = 128 * c;
        u32x4 cr[7], vr[2], orw[2];
#pragma unroll
        for (int j = 0; j < 7; ++j) cr[j] = ncr[j];
#pragma unroll
        for (int i = 0; i < 2; ++i) { const int id = tid + 512 * i; vr[i] = *(const u32x4*)(U + (rowbase + t0 + (id >> 3)) * NU + U_MV + hd * 64 + (id & 7) * 8); }
        const float ig0 = ngt[0], fg0 = ngt[1], ig1 = ngt[2], fg1 = ngt[3];
        const float lf0 = logsigf_(fg0), lf1 = logsigf_(fg1);
        const float ps = lf0 + lf1; float incl = ps;
#pragma unroll
        for (int o = 1; o < 64; o <<= 1) { const float t_ = __shfl_up(incl, o); if (lane >= o) incl += t_; }
        const float b0 = incl - ps + lf0, b1 = incl;
        const float a0 = ig0 - b0, a1 = ig1 - b1;
        float cmi = fmaxf(a0, a1);
#pragma unroll
        for (int o = 1; o < 64; o <<= 1) { const float t_ = __shfl_up(cmi, o); if (lane >= o) cmi = fmaxf(cmi, t_); }
        float cme = __shfl_up(cmi, 1); if (lane == 0) cme = -3.0e38f;
        const float cm0 = fmaxf(cme, a0), cm1 = cmi;
        const float amax = __shfl(cmi, 63), bL = __shfl(incl, 63);
        const float M0 = fmaxf(cm0, mprev), M1 = fmaxf(cm1, mprev), Mx = fmaxf(mprev, amax);
        const float wv0 = __expf(a0 - Mx), wv1 = __expf(a1 - Mx);
        const float dec = __expf(mprev - Mx);
        if (w == 0) {
            rowt[2 * lane] = -M0 * LOG2E; rowt[2 * lane + 1] = -M1 * LOG2E;
            colt[2 * lane] = a0 * LOG2E; colt[2 * lane + 1] = a1 * LOG2E;
            scl[2 * lane] = __expf(mprev - M0); scl[2 * lane + 1] = __expf(mprev - M1);
            dfl[2 * lane] = __expf(-(b0 + M0)); dfl[2 * lane + 1] = __expf(-(b1 + M1));
        }
        mprev = bL + Mx;
        {
            const float w0 = __shfl(wv0, 2 * (rblk & 31)), w1 = __shfl(wv1, 2 * (rblk & 31)), w2 = __shfl(wv0, 2 * (rblk & 31) + 1), w3 = __shfl(wv1, 2 * (rblk & 31) + 1);
            const float wts[4] = {w0, w1, w2, w3};
            const float ksc = (cch < 8) ? 1.0f : 0.125f;
            u32x4 opk[4], wpk[4];
#pragma unroll
            for (int p = 0; p < 4; ++p) {
                float xl[7], xh[7], cl[4], chh[4];
#pragma unroll
                for (int j = 0; j < 7; ++j) { const unsigned wd = cr[j][p]; xl[j] = __builtin_bit_cast(float, wd << 16); xh[j] = __builtin_bit_cast(float, wd & 0xffff0000u); }
#pragma unroll
                for (int j = 0; j < 4; ++j) { const f32x2_t c2 = *(const f32x2_t*)(CW + j * 128 + cch * 8 + 2 * p); cl[j] = c2.x; chh[j] = c2.y; }
#pragma unroll
                for (int i = 0; i < 4; ++i) {
                    float sl = cl[0] * xl[i] + cl[1] * xl[i + 1] + cl[2] * xl[i + 2] + cl[3] * xl[i + 3];
                    float sh = chh[0] * xh[i] + chh[1] * xh[i + 1] + chh[2] * xh[i + 2] + chh[3] * xh[i + 3];
                    sl = sl * sigmoidf_(sl) * ksc; sh = sh * sigmoidf_(sh) * ksc;
                    opk[i][p] = cvtpk(sl, sh); wpk[i][p] = cvtpk(sl * wts[i], sh * wts[i]);
                }
            }
            bf16_t* dst = ((cch < 8) ? Q : K) + (4 * rblk) * 72 + (cch & 7) * 8;
#pragma unroll
            for (int i = 0; i < 4; ++i) { *(u32x4*)(dst + i * 72) = opk[i]; if (cch >= 8) *(u32x4*)(WK + (4 * rblk + i) * 72 + (cch - 8) * 8) = wpk[i]; }
#pragma unroll
            for (int i = 0; i < 2; ++i) { const int id = tid + 512 * i; *(u32x4*)(VV + (id >> 3) * 72 + (id & 7) * 8) = vr[i]; }
        }
        lds_barrier();
#pragma unroll
        for (int i = 0; i < 2; ++i) orw[i] = *(const u32x4*)(U + (rowbase + t0 + ft) * NU + U_MO + hd * 64 + fv0 + 8 * i);
        {
            const int vb = w & 1, tb = w >> 1, t = 32 * tb + r;
            bf16x8 qf[4];
#pragma unroll
            for (int ks = 0; ks < 4; ++ks) qf[ks] = ld8(Q + t * 72 + 16 * ks + 8 * h);
            f32x16 acc;
#pragma unroll
            for (int e = 0; e < 16; ++e) acc[e] = 0.f;
#pragma unroll
            for (int ks = 0; ks < 4; ++ks) { const bf16x8 a = ld8(CL + (32 * vb + r) * 72 + 16 * ks + 8 * h); acc = MFMA32(a, qf[ks], acc); }
            const float sc = scl[t], rt = rowt[t];
#pragma unroll
            for (int e = 0; e < 16; ++e) acc[e] *= sc;
            float dn = 0.f;
#pragma unroll
            for (int ks = 0; ks < 4; ++ks)
#pragma unroll
                for (int j = 0; j < 8; ++j) dn += bf2f((unsigned short)qf[ks][j]) * NV[16 * ks + 8 * h + j];
            dn += __shfl_xor(dn, 32);
            float dsum = 0.f;
#pragma unroll
            for (int sb = 0; sb < 4; ++sb) {
                if (sb <= tb) {
                    f32x16 st;
#pragma unroll
                    for (int e = 0; e < 16; ++e) st[e] = 0.f;
#pragma unroll
                    for (int ks = 0; ks < 4; ++ks) { const bf16x8 a = ld8(K + (32 * sb + r) * 72 + 16 * ks + 8 * h); st = MFMA32(a, qf[ks], st); }
#pragma unroll
                    for (int e = 0; e < 16; ++e) { const int sl = crow(e, h); float v = st[e] * __builtin_amdgcn_exp2f(rt + colt[32 * sb + sl]); if (sb == tb && sl > r) v = 0.f; st[e] = v; dsum += v; }
#pragma unroll
                    for (int s2 = 0; s2 < 2; ++s2) { const bf16x8 pf = pack8(st, s2); const bf16x8 a = tr_frag<true>(lds3 + ML_V, 144, 32 * sb + 16 * s2, 32 * vb, lane); acc = MFMA32(a, pf, acc); }
                }
            }
            dsum += __shfl_xor(dsum, 32);
            const float den = dsum + sc * dn;
            const float inv = __builtin_amdgcn_rcpf(fmaxf(fabsf(den), dfl[t]));
#pragma unroll
            for (int e = 0; e < 16; ++e) H[t * 65 + 32 * vb + crow(e, h)] = acc[e] * inv;
        }
        lds_barrier();
        if (c + 1 < T / 128) ML_PREFETCH(c + 1);
        {
            float hv[16]; float ss = 0.f;
#pragma unroll
            for (int e = 0; e < 16; ++e) { hv[e] = H[ft * 65 + fv0 + e]; ss += hv[e] * hv[e]; }
            ss += __shfl_xor(ss, 1); ss += __shfl_xor(ss, 2);
            const float rn = __builtin_amdgcn_rsqf(ss * (1.f / 64) + EPS);
            bf16_t* mp = MIX + (rowbase + t0 + ft) * D + hd * 64 + fv0;
#pragma unroll
            for (int g = 0; g < 2; ++g) { float og[8]; unpack8(orw[g], og); float ov2[8];
#pragma unroll
                for (int e = 0; e < 8; ++e) ov2[e] = hv[8 * g + e] * rn * NG[fv0 + 8 * g + e] * sigmoidf_(og[e]);
                *(u32x4*)(mp + 8 * g) = pack8f(ov2); }
        }
        if (w < 4) {
            const int vb2 = w & 1, kb2 = w >> 1;
            f32x16 cacc;
#pragma unroll
            for (int e = 0; e < 16; ++e) cacc[e] = CF[(32 * vb2 + crow(e, h)) * 65 + 32 * kb2 + r] * dec;
#pragma unroll
            for (int s2 = 0; s2 < 8; ++s2) { const bf16x8 a = tr_frag<false>(lds3 + ML_V, 144, 16 * s2, 32 * vb2, lane); const bf16x8 bb = tr_frag<false>(lds3 + ML_WK, 144, 16 * s2, 32 * kb2, lane); cacc = MFMA32(a, bb, cacc); }
#pragma unroll
            for (int e = 0; e < 16; ++e) { CF[(32 * vb2 + crow(e, h)) * 65 + 32 * kb2 + r] = cacc[e]; CL[(32 * vb2 + crow(e, h)) * 72 + 32 * kb2 + r] = (bf16_t)f2bf(cacc[e]); }
        } else if (w < 6) {
            const int kb2 = w - 4; const bf16x8 ones = {0x3f80, 0x3f80, 0x3f80, 0x3f80, 0x3f80, 0x3f80, 0x3f80, 0x3f80};
            f32x16 nacc;
#pragma unroll
            for (int e = 0; e < 16; ++e) nacc[e] = 0.f;
#pragma unroll
            for (int s2 = 0; s2 < 8; ++s2) { const bf16x8 bb = tr_frag<false>(lds3 + ML_WK, 144, 16 * s2, 32 * kb2, lane); nacc = MFMA32(ones, bb, nacc); }
            if (h == 0) NV[32 * kb2 + r] = dec * NV[32 * kb2 + r] + nacc[0];
        }
        lds_barrier();
    }
#undef ML_PREFETCH
}
constexpr int HG_TOT = 0, HG_Q0 = 2048, HG_QD = 11264, HG_KD = 20480, HG_KE = 29696, HG_V = 38912, HG_ST = 48128, HG_OH = 66560;
DI void hgrn_unit(const bf16_t* U, bf16_t* MIX, const float* LBl, const float* hn, int b, int hd, unsigned char* lds, int tid_in) {
    int tid = tid_in; asm volatile("" : "+v"(tid));
    const int lane = tid & 63, r = lane & 31, h = lane >> 5, w = __builtin_amdgcn_readfirstlane(tid >> 6);
    float* TOT = (float*)(lds + HG_TOT); bf16_t* Q0 = (bf16_t*)(lds + HG_Q0); bf16_t* QD = (bf16_t*)(lds + HG_QD); bf16_t* KD = (bf16_t*)(lds + HG_KD);
    bf16_t* KE = (bf16_t*)(lds + HG_KE); bf16_t* VV = (bf16_t*)(lds + HG_V); bf16_t* ST = (bf16_t*)(lds + HG_ST); float* OH = (float*)(lds + HG_OH);
    const lds_cp lds3 = (lds_cp)lds;
    const size_t rowbase = (size_t)b * T;
    __syncthreads();
    for (int i = tid; i < 64 * 72; i += NTHREADS) ST[i] = 0;
    f32x16 sacc;
#pragma unroll
    for (int e = 0; e < 16; ++e) sacc[e] = 0.f;
    const int tA = tid >> 3, k0 = (tid & 7) * 8;
    float lbv[8], hnv[8];
#pragma unroll
    for (int e = 0; e < 8; ++e) { lbv[e] = LBl[hd * 64 + k0 + e]; hnv[e] = hn[k0 + e]; }
    u32x4 nq, nf, nv, ng;
#define HG_PREFETCH(c_) do { const bf16_t* rp_ = U + (rowbase + 64 * (c_) + tA) * NU + hd * 64 + k0; nq = *(const u32x4*)(rp_ + U_HQ); nf = *(const u32x4*)(rp_ + U_HF); nv = *(const u32x4*)(rp_ + U_HI); ng = *(const u32x4*)(rp_ + U_HG); } while (0)
    HG_PREFETCH(0);
    int cur = 0;
    for (int c = 0; c < T / 64; ++c) {
        const size_t row = rowbase + 64 * c + tA;
        const u32x4 qw = nq, fw = nf, vw = nv, gw = ng;
        if (c + 1 < T / 64) HG_PREFETCH(c + 1);
        float qv[8], kk[8], bc[8];
        { float qp[8], fp[8]; unpack8(qw, qp); unpack8(fw, fp);
#pragma unroll
          for (int e = 0; e < 8; ++e) { qv[e] = qp[e] * sigmoidf_(qp[e]); const float ex = __expf(-fp[e]); const float sg = __builtin_amdgcn_rcpf(1.f + ex), sn = ex * sg;
              bc[e] = __logf(lbv[e] + (1.f - lbv[e]) * sg); kk[e] = (1.f - lbv[e]) * sn; } }
#pragma unroll
        for (int o = 8; o < 64; o <<= 1) {
#pragma unroll
            for (int e = 0; e < 8; ++e) { const float t_ = __shfl_up(bc[e], o); if (lane >= o) bc[e] += t_; } }
        if ((lane >> 3) == 7) { *(f32x4*)(TOT + w * 64 + k0) = (f32x4){bc[0], bc[1], bc[2], bc[3]}; *(f32x4*)(TOT + w * 64 + k0 + 4) = (f32x4){bc[4], bc[5], bc[6], bc[7]}; }
        *(u32x4*)(VV + tA * 72 + k0) = vw;
        lds_barrier();
        float r1[8], bl[8];
        {
#pragma unroll
            for (int e = 0; e < 8; ++e) { r1[e] = 0.f; bl[e] = 0.f; }
            float pre[8];
#pragma unroll
            for (int e = 0; e < 8; ++e) pre[e] = 0.f;
#pragma unroll
            for (int w2 = 0; w2 < 8; ++w2) { const f32x4 a = *(const f32x4*)(TOT + w2 * 64 + k0), c4 = *(const f32x4*)(TOT + w2 * 64 + k0 + 4);
                const float tv[8] = {a.x, a.y, a.z, a.w, c4.x, c4.y, c4.z, c4.w};
#pragma unroll
                for (int e = 0; e < 8; ++e) { if (w2 < w) pre[e] += tv[e]; if (w2 < 4) r1[e] += tv[e]; bl[e] += tv[e]; } }
#pragma unroll
            for (int e = 0; e < 8; ++e) bc[e] += pre[e];
        }
        {
            float q0[8], qd[8], kd[8], ke[8];
#pragma unroll
            for (int e = 0; e < 8; ++e) { const float rr = (w >= 4) ? r1[e] : 0.f;
                q0[e] = qv[e] * __expf(bc[e]); qd[e] = qv[e] * __expf(bc[e] - rr); kd[e] = kk[e] * __expf(rr - bc[e]); ke[e] = kk[e] * __expf(bl[e] - bc[e]); }
            *(u32x4*)(Q0 + tA * 72 + k0) = pack8f(q0); *(u32x4*)(QD + tA * 72 + k0) = pack8f(qd); *(u32x4*)(KD + tA * 72 + k0) = pack8f(kd); *(u32x4*)(KE + tA * 72 + k0) = pack8f(ke);
        }
        lds_barrier();
        if (w < 4) {
            const int vb = w & 1, tb = w >> 1, t = 32 * tb + r;
            bf16x8 qf0[4], qfd[4];
#pragma unroll
            for (int ks = 0; ks < 4; ++ks) { qf0[ks] = ld8(Q0 + t * 72 + 16 * ks + 8 * h); qfd[ks] = ld8(QD + t * 72 + 16 * ks + 8 * h); }
            f32x16 acc;
#pragma unroll
            for (int e = 0; e < 16; ++e) acc[e] = 0.f;
            const bf16_t* STc = ST + cur * 64 * 72;
#pragma unroll
            for (int ks = 0; ks < 4; ++ks) { const bf16x8 a = ld8(STc + (32 * vb + r) * 72 + 16 * ks + 8 * h); acc = MFMA32(a, qf0[ks], acc); }
#pragma unroll
            for (int sb = 0; sb < 2; ++sb) {
                if (sb <= tb) {
                    f32x16 st;
#pragma unroll
                    for (int e = 0; e < 16; ++e) st[e] = 0.f;
#pragma unroll
                    for (int ks = 0; ks < 4; ++ks) { const bf16x8 a = ld8(KD + (32 * sb + r) * 72 + 16 * ks + 8 * h); st = MFMA32(a, (sb == tb) ? qfd[ks] : qf0[ks], st); }
                    if (sb == tb) {
#pragma unroll
                        for (int e = 0; e < 16; ++e) if (crow(e, h) > r) st[e] = 0.f; }
#pragma unroll
                    for (int s2 = 0; s2 < 2; ++s2) { const bf16x8 pf = pack8(st, s2); const bf16x8 a = tr_frag<true>(lds3 + HG_V, 144, 32 * sb + 16 * s2, 32 * vb, lane); acc = MFMA32(a, pf, acc); }
                }
            }
#pragma unroll
            for (int e = 0; e < 16; ++e) OH[t * 65 + 32 * vb + crow(e, h)] = acc[e];
        } else {
            const int vb = w & 1, kb = (w >> 1) & 1;
            float dsum = 0.f;
#pragma unroll
            for (int w2 = 0; w2 < 8; ++w2) dsum += TOT[w2 * 64 + 32 * kb + r];
            const float dec = __expf(dsum);
#pragma unroll
            for (int e = 0; e < 16; ++e) sacc[e] *= dec;
#pragma unroll
            for (int s2 = 0; s2 < 4; ++s2) { const bf16x8 a = tr_frag<false>(lds3 + HG_V, 144, 16 * s2, 32 * vb, lane); const bf16x8 bb = tr_frag<false>(lds3 + HG_KE, 144, 16 * s2, 32 * kb, lane); sacc = MFMA32(a, bb, sacc); }
            bf16_t* STn = ST + (cur ^ 1) * 64 * 72;
#pragma unroll
            for (int e = 0; e < 16; ++e) STn[(32 * vb + crow(e, h)) * 72 + 32 * kb + r] = (bf16_t)f2bf(sacc[e]);
        }
        lds_barrier();
        {
            float ov[8]; float ss = 0.f;
#pragma unroll
            for (int e = 0; e < 8; ++e) { ov[e] = OH[tA * 65 + k0 + e]; ss += ov[e] * ov[e]; }
            ss += __shfl_xor(ss, 1); ss += __shfl_xor(ss, 2); ss += __shfl_xor(ss, 4);
            const float rn = __builtin_amdgcn_rsqf(ss * (1.f / 64) + EPS);
            float gp[8]; unpack8(gw, gp);
#pragma unroll
            for (int e = 0; e < 8; ++e) ov[e] = ov[e] * rn * hnv[e] * (gp[e] * sigmoidf_(gp[e]));
            *(u32x4*)(MIX + row * D + 768 + hd * 64 + k0) = pack8f(ov);
        }
        cur ^= 1;
    }
#undef HG_PREFETCH
    __syncthreads();
}
#define LAS __attribute__((address_space(3)))
#define XB_TMO      128
#define XB_XCNT(j)  (256  + 64 * (j))
#define XB_XSUB(j)  (1280 + 64 * (j))
#define XB_XGEN(j)  (2304 + 64 * (j))
#define XB_TOP      3328
#define XB_TOPGEN   3392
#define XCD_BAR_WORDS 3456
#define XB_SPIN_CAP (1u << 18)

__device__ __forceinline__ unsigned xb_ld(unsigned* p)              { return __hip_atomic_load(p, __ATOMIC_RELAXED, __HIP_MEMORY_SCOPE_AGENT); }
__device__ __forceinline__ unsigned xb_add(unsigned* p, unsigned v) { return __hip_atomic_fetch_add(p, v, __ATOMIC_RELAXED, __HIP_MEMORY_SCOPE_AGENT); }
__device__ __forceinline__ unsigned xb_xcc_id() { return (unsigned)__builtin_amdgcn_s_getreg((3 << 11) | 20) & 0xFu; }
#define XB_SPIN(cond, bar) do { unsigned _sp = 0; while (cond) { __builtin_amdgcn_s_sleep(1); \
    if ((++_sp & 255u) == 0u) { if (xb_ld(&(bar)[XB_TMO])) break; if (_sp > XB_SPIN_CAP) { atomicAdd(&(bar)[XB_TMO], 1u); break; } } } } while (0)

struct XcdBarrier {
    unsigned* bar; unsigned x;
    volatile LAS unsigned* st;
};

__device__ __forceinline__ XcdBarrier xcd_barrier_post(unsigned* bar, volatile LAS unsigned* st) {
    XcdBarrier b; b.bar = bar; b.x = xb_xcc_id(); b.st = st;
    if (threadIdx.x == 0) (void)xb_add(&bar[XB_XCNT(b.x)], 1u);
    return b;
}
__device__ __forceinline__ void xcd_barrier_complete(unsigned* bar, unsigned x, unsigned& nloc, unsigned& nx) {
    const unsigned G = gridDim.x * gridDim.y * gridDim.z;
    unsigned sum, cnt, mine, sp = 0u;
    for (;;) {
        sum = 0u; cnt = 0u; mine = 0u;
#pragma unroll
        for (unsigned j = 0; j < 16; ++j) { const unsigned c = xb_ld(&bar[XB_XCNT(j)]); sum += c; cnt += (c > 0u) ? 1u : 0u; mine = (j == x) ? c : mine; }
        if (sum == G) break;
        __builtin_amdgcn_s_sleep(1);
        if ((++sp & 255u) == 0u) { if (xb_ld(&bar[XB_TMO])) break; if (sp > XB_SPIN_CAP) { atomicAdd(&bar[XB_TMO], 1u); break; } }
    }
    nloc = mine > 0u ? mine : 1u; nx = cnt > 0u ? cnt : 1u;
}

__device__ __forceinline__ void xcd_barrier(const XcdBarrier& b, int tid_in) {
    asm volatile("s_waitcnt vmcnt(0)" ::: "memory");
    __syncthreads();
    if (tid_in == 0) {
        unsigned* bar = b.bar;
        __builtin_amdgcn_s_waitcnt(0);
        unsigned nloc = b.st[0], nx = b.st[1];
        if (nloc == 0u) { xcd_barrier_complete(bar, b.x, nloc, nx); b.st[0] = nloc; b.st[1] = nx; }
        const unsigned old = xb_add(&bar[XB_XSUB(b.x)], 1u);
        const unsigned gen = old / nloc;
        if (old + 1u == (gen + 1u) * nloc) {
            __builtin_amdgcn_fence(__ATOMIC_RELEASE, "agent");
            asm volatile("s_waitcnt vmcnt(0)" ::: "memory");
            const unsigned og = xb_add(&bar[XB_TOP], 1u);
            const unsigned tg = og / nx;
            if (og + 1u == (tg + 1u) * nx) xb_add(&bar[XB_TOPGEN], 1u);
            else XB_SPIN(xb_ld(&bar[XB_TOPGEN]) == tg, bar);
            __builtin_amdgcn_fence(__ATOMIC_ACQUIRE, "agent");
            xb_add(&bar[XB_XGEN(b.x)], 1u);
            asm volatile("s_waitcnt vmcnt(0)" ::: "memory");
        } else {
            XB_SPIN(xb_ld(&bar[XB_XGEN(b.x)]) == gen, bar);
            __builtin_amdgcn_fence(__ATOMIC_ACQUIRE, "agent");
            asm volatile("s_waitcnt vmcnt(0)" ::: "memory");
        }
    }
    __syncthreads();
}

#ifdef NO_G1
#define GC1 if (0)
#else
#define GC1
#endif
#ifdef NO_G2
#define GC2 if (0)
#else
#define GC2
#endif
#ifdef NO_G3
#define GC3 if (0)
#else
#define GC3
#endif
#ifdef NO_G4
#define GC4 if (0)
#else
#define GC4
#endif
#ifndef REP_MIX
#define REP_MIX 1
#endif
#ifndef REP_G1
#define REP_G1 1
#endif
#ifndef REP_UP
#define REP_UP 1
#endif
#ifndef MK_ONE_LAUNCH
#define MK_ONE_LAUNCH 1
#endif
constexpr int N_PHASES = 1 + 6 * DEPTH;
__global__ void __launch_bounds__(NTHREADS, 2) hymba_fwd(Params P) {
    extern __shared__ __attribute__((aligned(16))) unsigned char lds[];
    cg::grid_group grid = cg::this_grid();
    const int wv_k = __builtin_amdgcn_readfirstlane(threadIdx.x >> 6);
#define MYTID ({ int w__ = wv_k; asm volatile("" : "+s"(w__)); int l__ = (int)__builtin_amdgcn_mbcnt_hi(~0u, __builtin_amdgcn_mbcnt_lo(~0u, 0u)); asm volatile("" : "+v"(l__)); w__ * 64 + l__; })
#define LTID int tid = MYTID; asm volatile("" : "+v"(tid));
#define PTRS unsigned char* ws = P.ws; asm volatile("" : "+s"(ws)); unsigned* CTL = (unsigned*)(ws + WS_CTL); (void)CTL; \
    const float* PR = (const float*)(ws + WS_PAR); (void)PR; float* RP = (float*)(ws + WS_ROPE); (void)RP; float* SS = (float*)(ws + WS_SS); (void)SS; float* GATE = (float*)(ws + WS_GATE); (void)GATE; \
    bf16_t* XB = (bf16_t*)(ws + WS_XB); (void)XB; bf16_t* U = (bf16_t*)(ws + WS_U); (void)U; bf16_t* MIX = (bf16_t*)(ws + WS_MIX); (void)MIX; bf16_t* HB = (bf16_t*)(ws + WS_H); (void)HB; \
    unsigned char* wb = ws + WS_W + (size_t)l * W_LAYER; (void)wb;
    const int lo = P.ph_lo, hi = P.ph_hi;
#define IN(k) (lo <= (k) && (k) < hi)
    volatile LAS unsigned* bst = (volatile LAS unsigned*)((LAS unsigned char*)lds + LDS_BYTES - 32);
    if (threadIdx.x < 2) bst[threadIdx.x] = 0u;
    __syncthreads();
    XcdBarrier xbar = xcd_barrier_post((unsigned*)(P.ws + WS_CTL) + 1024, bst);
#define SEAM(k) do { if (IN(k) && IN((k) + 1)) { XcdBarrier xb2_ = xbar; asm volatile("" : "+s"(xb2_.bar)); xcd_barrier(xb2_, MYTID); } } while (0)
    if (P.ph_hi < 0) grid.sync();
#ifndef REP_P0
#define REP_P0 1
#endif
    if (IN(0)) { const int l = 0; PTRS for (int rep = 0; rep < REP_P0; ++rep) { p0_prep(P, lds, MYTID); { LTID row_prep(P.x, XB, SS, P.w_in, P.norm1_g, P.gate_b, GATE, (float*)lds, tid); } } }
    SEAM(0);
#ifdef PROBE_SYNC
    for (int i_ = 0; i_ < 10; ++i_) grid.sync();
#endif
#pragma unroll
    for (int l = 0; l < DEPTH; ++l) {
        const int pb = 1 + 6 * l;
        if (IN(pb + 0)) { PTRS
            if (l > 0) { LTID gates_prep(XB, SS + (2 * l) * M, (const float*)(ws + WS_WG) + l * 8 * D, PR + PAR_GB + l * 8, GATE, (float*)lds, tid); }
            pg8::Gemm g{XB, (const bf16_t*)(wb + W_IN), M, NU, D}; pg8::StaticOrder S; S.init(M, NU, gridDim.x, (int)blockIdx.x);
            pg8::EpiIn E{U, NU, SS + (2 * l) * M, RP, PR + PAR_QN + l * 64, PR + PAR_KN + l * 64};
            for (int rep = 0; rep < ((l == 0) ? REP_G1 : 1); ++rep)
            GC1 pg8::gemm_phase<pg8::EpiIn, pg8::StaticOrder, true, true>((PG8_LAS unsigned char*)lds, g, S, E, MYTID);
        }
        SEAM(pb + 0);
        if (IN(pb + 2)) { PTRS LTID
            volatile int* slot = (volatile int*)(lds + LDS_BYTES - 64);
            for (int rep = 0; rep < ((l == 0) ? REP_MIX : 1); ++rep)
            for (;;) {
                __syncthreads();
                if (tid == 0) *slot = (int)atomicAdd(CTL + 16 * l + rep, 1u);
                __syncthreads();
                const int id = *slot;
                if (id >= 128 + 1024) break;
                if (id < 64) {
#ifndef NO_ML
 mlstm_unit(U, GATE, MIX, PR + PAR_CW + l * 2048, PR + PAR_MN + l * 64, id >> 2, id & 3, lds, tid);
#endif
 }
                else if (id < 128) {
#ifndef NO_HG
 hgrn_unit(U, MIX, (const float*)(ws + WS_LB) + l * 256, PR + PAR_HN + l * 64, (id - 64) >> 2, (id - 64) & 3, lds, tid);
#endif
 }
                else {
#ifndef NO_AT
 const int a = id - 128; const int qb = 15 - (a >> 6), bh = a & 63;
                    int lsel = l; asm volatile("" : "+s"(lsel));
                    const float lam_init = (lsel == 0) ? 0.2f : 0.35550906759096926f;
                    const float lam = PR[PAR_LAMV + lsel];
                    attn_unit(U, MIX, bh >> 2, bh & 3, qb, lam, 1.f - lam_init, PR + PAR_SUB + l * 128, lds, tid);
#endif
 }
            }
        }
        SEAM(pb + 2);
        if (IN(pb + 3)) { PTRS
            pg8::Gemm g{MIX, (const bf16_t*)(wb + W_OUT), M, D, D}; pg8::StaticOrder S; S.init(M, D, gridDim.x, (int)blockIdx.x);
            pg8::EpiResidBf E{XB, P.out, D, SS + (2 * l + 1) * M, 0};
            GC2 pg8::gemm_phase<pg8::EpiResidBf, pg8::StaticOrder, true, true>((PG8_LAS unsigned char*)lds, g, S, E, MYTID);
        }
        SEAM(pb + 3);
        if (IN(pb + 4)) { PTRS
            pg8::Gemm g{XB, (const bf16_t*)(wb + W_UP), M, FF, D}; pg8::StaticOrder S; S.init(M, FF, gridDim.x, (int)blockIdx.x);
            pg8::EpiScaleBf16<1> E{HB, FF, SS + (2 * l + 1) * M};
            for (int rep = 0; rep < ((l == 0) ? REP_UP : 1); ++rep)
            GC3 pg8::gemm_phase<pg8::EpiScaleBf16<1>, pg8::StaticOrder, true, true>((PG8_LAS unsigned char*)lds, g, S, E, MYTID);
        }
        SEAM(pb + 4);
        if (IN(pb + 5)) { PTRS
            pg8::Gemm g{HB, (const bf16_t*)(wb + W_DN), M, D, FF}; pg8::StaticOrder S; S.init(M, D, gridDim.x, (int)blockIdx.x);
#ifdef PROBE_DN
            if (l == 0) { pg8::EpiScaleBf16<0> E2{XB, D, SS}; pg8::gemm_phase<pg8::EpiScaleBf16<0>, pg8::StaticOrder, true, true>((PG8_LAS unsigned char*)lds, g, S, E2, MYTID); }
#endif
            pg8::EpiResidBf E{XB, P.out, D, SS + ((2 * l + 2) & 3) * M, (l + 1 < DEPTH) ? 0 : 1};
            GC4 pg8::gemm_phase<pg8::EpiResidBf, pg8::StaticOrder, true, true>((PG8_LAS unsigned char*)lds, g, S, E, MYTID);
        }
        SEAM(pb + 5);
    }
#undef IN
#undef SEAM
}

extern "C" void kernel_launch(void* const* d_in, const int* in_sizes, int n_in, void* d_out, int out_size, void* d_ws, size_t ws_size, hipStream_t stream) {
    static int grid = 0;
    if (grid == 0) {
        if (n_in != 16 || in_sizes[0] != M * D || out_size != M * D || ws_size < WS_END) { fprintf(stderr, "kernel_launch: unexpected shapes (n_in %d in0 %d out %d ws %zu)\n", n_in, n_in > 0 ? in_sizes[0] : -1, out_size, ws_size); grid = -1; return; }
        int dev = 0, cus = 0, per_cu = 0;
        hipGetDevice(&dev); hipDeviceGetAttribute(&cus, hipDeviceAttributeMultiprocessorCount, dev);
        if (hipFuncSetAttribute((const void*)hymba_fwd, hipFuncAttributeMaxDynamicSharedMemorySize, LDS_BYTES) != hipSuccess) { fprintf(stderr, "kernel_launch: hipFuncSetAttribute failed\n"); grid = -1; return; }
        if (hipOccupancyMaxActiveBlocksPerMultiprocessor(&per_cu, (const void*)hymba_fwd, NTHREADS, LDS_BYTES) != hipSuccess || per_cu < 1) { fprintf(stderr, "kernel_launch: occupancy query gave %d\n", per_cu); per_cu = 1; }
        (void)hipGetLastError();
        grid = cus * per_cu;
        fprintf(stderr, "kernel_launch: grid %d (%d CUs x %d)\n", grid, cus, per_cu);
    }
    if (grid < 0) return;
    hipMemsetAsync((char*)d_ws + WS_CTL, 0, CTL_BYTES, stream);
    Params p{};
    p.x = (const float*)d_in[0]; p.norm1_g = (const float*)d_in[1]; p.w_in = (const float*)d_in[2]; p.conv_w = (const float*)d_in[3]; p.gate_b = (const float*)d_in[4]; p.mnorm_g = (const float*)d_in[5];
    p.qn_g = (const float*)d_in[6]; p.kn_g = (const float*)d_in[7]; p.lam = (const float*)d_in[8]; p.subln_g = (const float*)d_in[9]; p.lb_param = (const float*)d_in[10]; p.hnorm_g = (const float*)d_in[11];
    p.w_out = (const float*)d_in[12]; p.norm2_g = (const float*)d_in[13]; p.w_up = (const float*)d_in[14]; p.w_down = (const float*)d_in[15];
    p.out = (float*)d_out; p.ws = (unsigned char*)d_ws;
#if MK_ONE_LAUNCH
    p.ph_lo = 0; p.ph_hi = N_PHASES;
    void* args[] = {&p};
    hipError_t e = hipLaunchCooperativeKernel((const void*)hymba_fwd, dim3(grid), dim3(NTHREADS), args, LDS_BYTES, stream);
    if (e != hipSuccess) fprintf(stderr, "cooperative launch failed: %s (grid %d)\n", hipGetErrorString(e), grid);
#else
    for (int ph = 0; ph < N_PHASES; ++ph) { p.ph_lo = ph; p.ph_hi = ph + 1; hipLaunchKernelGGL(hymba_fwd, dim3(grid), dim3(NTHREADS), LDS_BYTES, stream, p); }
#endif
}
```

```cpp
#include <hip/hip_runtime.h>
#include <hip/hip_cooperative_groups.h>
#include <cstdio>
#include <cstdint>
namespace cg = cooperative_groups;
namespace pg8 {
#define PG8_LAS __attribute__((address_space(3)))
typedef unsigned short bf16_t;
typedef short bf16x8 __attribute__((ext_vector_type(8)));
typedef float f32x4 __attribute__((ext_vector_type(4)));
typedef unsigned u32x4 __attribute__((ext_vector_type(4)));
constexpr int BM = 256, BK = 64, HALF = 128, HTB = HALF * BK * 2  , STAGE_BYTES = 8 * HTB, NXCD = 8, WGM = 8;

__host__ __device__ __forceinline__ int lds_byte(int r, int c) { const int st = (r >> 4) * 2 + (c >> 5), rr = r & 15, cc = c & 31, ob = rr * 64 + cc * 2; return st * 1024 + (ob ^ (((ob >> 9) & 1) << 5)); }
__host__ __device__ __forceinline__ void stage_rc(int b, int& R, int& C) { const int st = b / 1024, sb = b % 1024, swz = sb ^ (((sb >> 9) & 1) << 5); R = (st >> 1) * 16 + swz / 64; C = (st & 1) * 32 + (swz % 64) / 2; }
__host__ __device__ __forceinline__ int perm32(int rho) { const int n = rho >> 4, i = rho & 15; return 8 * (i >> 2) + 4 * n + (i & 3); }

struct Unit { int pm, pn; };
struct Gemm { const bf16_t* A; const bf16_t* Bt; int M, N, K; };

struct StaticOrder {
    int nM, nN, nwg, G, c;
    __host__ __device__ void init(int M, int N, int G_, int c_) { nM = M / BM; nN = N / BM; nwg = nM * nN; G = G_; c = c_; }
    __host__ __device__ bool next(int i, Unit& u) const {
        const long L = (long)i * G + c; if (L >= nwg) return false;
        int wgid = (int)L; { const int q = nwg / NXCD, r = nwg % NXCD, xcd = wgid % NXCD, off = wgid / NXCD; wgid = (xcd < r ? xcd * (q + 1) : r * (q + 1) + (xcd - r) * q) + off; }
        const int nig = WGM * nN, gid = wgid / nig, fm = gid * WGM, gsz = (nM - fm) < WGM ? (nM - fm) : WGM;
        u.pm = fm + ((wgid % nig) % gsz); u.pn = (wgid % nig) / gsz; return true;
    }
    __device__ __forceinline__ void a_ready(const Unit&) const {}
    __device__ __forceinline__ void done(const Unit&) const {}
};

__device__ __forceinline__ unsigned cvt_pk_bf16(float lo, float hi) { unsigned r; asm volatile("v_cvt_pk_bf16_f32 %0, %1, %2" : "=v"(r) : "v"(lo), "v"(hi)); return r; }
typedef float f32x2 __attribute__((ext_vector_type(2)));
template <int ACT> struct EpiScaleBf16 {
    static constexpr bool PERM = true, AFTER_DRAIN = false;
    bf16_t* O; int ldc; const float* ss;
    __device__ __forceinline__ void operator()(const f32x4 (&acc)[2][2][4][2], const Unit& u, int wr, int wc, int fr, int fq) const {
        const int row0 = u.pm * BM + wr * 64 + fr; const int col0 = u.pn * BM + wc * 32 + 8 * fq;
#pragma unroll
        for (int ai = 0; ai < 2; ++ai)
#pragma unroll
            for (int m = 0; m < 4; ++m) { const int row = row0 + ai * HALF + m * 16; const float s = __builtin_amdgcn_rsqf(ss[row] * (1.0f / 1024.0f) + 1e-6f); bf16_t* rowp = O + (size_t)row * ldc + col0;
#pragma unroll
                for (int bj = 0; bj < 2; ++bj) { f32x4 v0 = acc[ai][bj][m][0] * s, v1 = acc[ai][bj][m][1] * s;
                    if (ACT == 1) {
#pragma unroll
                        for (int e = 0; e < 4; ++e) { float a = v0[e] > 0.f ? v0[e] : 0.f; v0[e] = a * a; float b = v1[e] > 0.f ? v1[e] : 0.f; v1[e] = b * b; } }
                    u32x4 w; w.x = cvt_pk_bf16(v0[0], v0[1]); w.y = cvt_pk_bf16(v0[2], v0[3]); w.z = cvt_pk_bf16(v1[0], v1[1]); w.w = cvt_pk_bf16(v1[2], v1[3]);
                    *(u32x4*)(rowp + bj * HALF) = w; }
                if (m & 1) asm volatile("" ::: "memory"); }
    }
};
struct EpiResidBf {
    static constexpr bool PERM = true, AFTER_DRAIN = false;
    bf16_t* xb; float* out; int ldc; float* ssn; int last;
    __device__ __forceinline__ void operator()(const f32x4 (&acc)[2][2][4][2], const Unit& u, int wr, int wc, int fr, int fq) const {
        const int row0 = u.pm * BM + wr * 64 + fr; const int col0 = u.pn * BM + wc * 32 + 8 * fq;
#pragma unroll
        for (int ai = 0; ai < 2; ++ai) {
            u32x4 bs[4][2];
#pragma unroll
            for (int m = 0; m < 4; ++m) { const size_t off = (size_t)(row0 + ai * HALF + m * 16) * ldc + col0;
#pragma unroll
                for (int bj = 0; bj < 2; ++bj) bs[m][bj] = *(const u32x4*)(xb + off + bj * HALF); }
#pragma unroll
            for (int m = 0; m < 4; ++m) { const int row = row0 + ai * HALF + m * 16; const size_t off = (size_t)row * ldc + col0; float sq = 0.f;
#pragma unroll
                for (int bj = 0; bj < 2; ++bj) { const size_t idx = off + bj * HALF; const u32x4 b = bs[m][bj];
                    const f32x4 b0 = {__builtin_bit_cast(float, b.x << 16), __builtin_bit_cast(float, b.x & 0xffff0000u), __builtin_bit_cast(float, b.y << 16), __builtin_bit_cast(float, b.y & 0xffff0000u)};
                    const f32x4 b1 = {__builtin_bit_cast(float, b.z << 16), __builtin_bit_cast(float, b.z & 0xffff0000u), __builtin_bit_cast(float, b.w << 16), __builtin_bit_cast(float, b.w & 0xffff0000u)};
                    const f32x4 v0 = b0 + acc[ai][bj][m][0], v1 = b1 + acc[ai][bj][m][1];
                    if (last) { *(f32x4*)(out + idx) = v0; *(f32x4*)(out + idx + 4) = v1; }
                    else {
                        sq += (v0[0] * v0[0] + v0[1] * v0[1]) + (v0[2] * v0[2] + v0[3] * v0[3]) + (v1[0] * v1[0] + v1[1] * v1[1]) + (v1[2] * v1[2] + v1[3] * v1[3]);
                        u32x4 w; w.x = cvt_pk_bf16(v0[0], v0[1]); w.y = cvt_pk_bf16(v0[2], v0[3]); w.z = cvt_pk_bf16(v1[0], v1[1]); w.w = cvt_pk_bf16(v1[2], v1[3]);
                        *(u32x4*)(xb + idx) = w; } }
                if (!last) { sq += __shfl_xor(sq, 16); sq += __shfl_xor(sq, 32); if (fq == 0) atomicAdd(ssn + row, sq); } }
            asm volatile("" ::: "memory"); }
    }
};
struct EpiIn {
    static constexpr bool PERM = true, AFTER_DRAIN = false;
    bf16_t* O; int ldc; const float* ss; const float* RP; const float* qg; const float* kg;
    __device__ __forceinline__ void operator()(f32x4 (&acc)[2][2][4][2], const Unit& u, int wr, int wc, int fr, int fq) const {
        const int row0 = u.pm * BM + wr * 64 + fr; const int col0 = u.pn * BM + wc * 64 + 8 * fq;
        const bool qk = (u.pn >= 4) && (u.pn < 8);
        if (qk) {
            const bool isq = u.pn < 6; const float* gn = (isq ? qg : kg) + 8 * fq;
            float gv[2][8];
#pragma unroll
            for (int bj = 0; bj < 2; ++bj)
#pragma unroll
                for (int j = 0; j < 8; ++j) gv[bj][j] = gn[32 * bj + j];
            const float qs = isq ? 0.125f * 1.4426950408889634f : 1.0f;
            f32x4 rpn[4] = {{1.f, 0.f, 1.f, 0.f}, {1.f, 0.f, 1.f, 0.f}, {1.f, 0.f, 1.f, 0.f}, {1.f, 0.f, 1.f, 0.f}};
            const bool roper = fq < 2;
            if (roper) { const float* rp = RP + (size_t)(row0 & 2047) * 16; rpn[0] = *(const f32x4*)rp; rpn[1] = *(const f32x4*)(rp + 4); rpn[2] = *(const f32x4*)(rp + 8); rpn[3] = *(const f32x4*)(rp + 12); }
#pragma unroll
            for (int g = 0; g < 8; ++g) { const int ai = g >> 2, m = g & 3; const int row = row0 + ai * HALF + m * 16; bf16_t* rowp = O + (size_t)row * ldc + col0;
                const f32x4 a = rpn[0], b = rpn[1], c = rpn[2], d = rpn[3];
                if (g < 7 && roper) { const int rown = row0 + ((g + 1) >> 2) * HALF + ((g + 1) & 3) * 16; const float* rp = RP + (size_t)(rown & 2047) * 16;
                    rpn[0] = *(const f32x4*)rp; rpn[1] = *(const f32x4*)(rp + 4); rpn[2] = *(const f32x4*)(rp + 8); rpn[3] = *(const f32x4*)(rp + 12); }
                f32x4 c0 = (f32x4){a.x, a.z, b.x, b.z}, s0 = (f32x4){a.y, a.w, b.y, b.w}, c1 = (f32x4){c.x, c.z, d.x, d.z}, s1 = (f32x4){c.y, c.w, d.y, d.w};
                if (fq == 0) { s0 = -s0; s1 = -s1; }
                const float s = __builtin_amdgcn_rsqf(ss[row] * (1.0f / 1024.0f) + 1e-6f);
                f32x4 v[2][2]; float p = 0.f;
#pragma unroll
                for (int bj = 0; bj < 2; ++bj) { v[bj][0] = acc[ai][bj][m][0] * s; v[bj][1] = acc[ai][bj][m][1] * s;
                    p += (v[bj][0][0] * v[bj][0][0] + v[bj][0][1] * v[bj][0][1]) + (v[bj][0][2] * v[bj][0][2] + v[bj][0][3] * v[bj][0][3]) + (v[bj][1][0] * v[bj][1][0] + v[bj][1][1] * v[bj][1][1]) + (v[bj][1][2] * v[bj][1][2] + v[bj][1][3] * v[bj][1][3]); }
                p += __shfl_xor(p, 16); p += __shfl_xor(p, 32);
                const float rg = __builtin_amdgcn_rsqf(p * (1.0f / 64.0f) + 1e-6f);
#pragma unroll
                for (int bj = 0; bj < 2; ++bj) {
                    f32x4 v0 = v[bj][0] * rg, v1 = v[bj][1] * rg;
                    v0 = v0 * (f32x4){gv[bj][0], gv[bj][1], gv[bj][2], gv[bj][3]}; v1 = v1 * (f32x4){gv[bj][4], gv[bj][5], gv[bj][6], gv[bj][7]};
                    if (bj == 0) {
                        f32x4 o0, o1;
#pragma unroll
                        for (int e = 0; e < 4; ++e) { o0[e] = __shfl_xor(v0[e], 16); o1[e] = __shfl_xor(v1[e], 16); }
                        v0 = v0 * c0 + o0 * s0; v1 = v1 * c1 + o1 * s1; }
                    v0 = v0 * qs; v1 = v1 * qs;
                    u32x4 w; w.x = cvt_pk_bf16(v0[0], v0[1]); w.y = cvt_pk_bf16(v0[2], v0[3]); w.z = cvt_pk_bf16(v1[0], v1[1]); w.w = cvt_pk_bf16(v1[2], v1[3]);
                    *(u32x4*)(rowp + bj * 32) = w; }
                asm volatile("" ::: "memory"); }
        } else {
#pragma unroll
            for (int ai = 0; ai < 2; ++ai)
#pragma unroll
                for (int m = 0; m < 4; ++m) { const int row = row0 + ai * HALF + m * 16; const float s = __builtin_amdgcn_rsqf(ss[row] * (1.0f / 1024.0f) + 1e-6f); bf16_t* rowp = O + (size_t)row * ldc + col0;
#pragma unroll
                    for (int bj = 0; bj < 2; ++bj) { const f32x4 v0 = acc[ai][bj][m][0] * s, v1 = acc[ai][bj][m][1] * s;
                        u32x4 w; w.x = cvt_pk_bf16(v0[0], v0[1]); w.y = cvt_pk_bf16(v0[2], v0[3]); w.z = cvt_pk_bf16(v1[0], v1[1]); w.w = cvt_pk_bf16(v1[2], v1[3]);
                        *(u32x4*)(rowp + bj * 32) = w; }
                    if (m & 1) asm volatile("" ::: "memory"); }
        }
    }
};
template <class Epi, class Sched, bool ALIGN_EPI = false, bool SP2 = false>
__device__ __forceinline__ void gemm_phase(PG8_LAS unsigned char* lds, const Gemm g, const Sched& S, const Epi& E, int tid_in) {
    int tid_l = tid_in; asm volatile("" : "+v"(tid_l));
    const int tid = tid_l, wid = __builtin_amdgcn_readfirstlane(tid >> 6), lane = tid & 63, wr = wid >> 2, wc = wid & 3, fr = lane & 15, fq = lane >> 4;
    const int K = g.K, nt = K / BK;
    unsigned voffA[2], voffB[2];
#pragma unroll
    for (int i = 0; i < 2; ++i) { int R, C; stage_rc(tid * 16 + i * 8192, R, C); const int Rb = Epi::PERM ? ((R & ~31) + perm32(R & 31)) : R;
        voffA[i] = (unsigned)(R * K + C) * 2u; voffB[i] = (unsigned)(Rb * K + C) * 2u; }
    const size_t kstep = (size_t)(BK * 2);
    const size_t hstep = (size_t)HALF * K * 2;
    const size_t tstep = 2 * hstep;
    const unsigned ldsw = (unsigned)wid * 1024u;
    const int aoff = lds_byte(wr * 64 + fr, fq * 8), boff = lds_byte(wc * 32 + fr, fq * 8);
#define PG8_SA(b, h) (((b) * 2 + (h)) * HTB)
#define PG8_SB(b, h) ((4 + (b) * 2 + (h)) * HTB)
#define PG8_STAGE(bufoff, gbase, voff) do { _Pragma("unroll") for (int _i = 0; _i < 2; ++_i) \
        __builtin_amdgcn_global_load_lds((const unsigned*)((const char*)(gbase) + (voff)[_i]), (PG8_LAS unsigned*)(lds + (bufoff) + ldsw + _i * 8192), 16, 0, 0); } while (0)
#define PG8_LDA(dst, b, h) do { _Pragma("unroll") for (int m = 0; m < 4; ++m) _Pragma("unroll") for (int k = 0; k < 2; ++k) dst[m][k] = *(const PG8_LAS bf16x8*)(lds + PG8_SA(b, h) + aoff + m * 2048 + k * 1024); } while (0)
#define PG8_LDB(dst, b, h) do { _Pragma("unroll") for (int n = 0; n < 2; ++n) _Pragma("unroll") for (int k = 0; k < 2; ++k) dst[n][k] = *(const PG8_LAS bf16x8*)(lds + PG8_SB(b, h) + boff + n * 2048 + k * 1024); } while (0)
#define PG8_MMA(ai, bj, At, Bt) do { __builtin_amdgcn_s_setprio(1); _Pragma("unroll") for (int m = 0; m < 4; ++m) _Pragma("unroll") for (int n = 0; n < 2; ++n) _Pragma("unroll") for (int k = 0; k < 2; ++k) \
        acc[ai][bj][m][n] = __builtin_amdgcn_mfma_f32_16x16x32_bf16(Bt[n][k], At[m][k], acc[ai][bj][m][n], 0, 0, 0); __builtin_amdgcn_s_setprio(0); } while (0)
#define PG8_WAIT_V(n) asm volatile("s_waitcnt vmcnt(" #n ")" ::: "memory")
#define PG8_WAIT_L(n) asm volatile("s_waitcnt lgkmcnt(" #n ")" ::: "memory")
#define PG8_BAR __builtin_amdgcn_s_barrier()
#define PG8_SCHED __builtin_amdgcn_sched_barrier(0)
    Unit cur, nxt; int ui = 0;
    if (!S.next(0, cur)) return;
    f32x4 acc[2][2][4][2];
#pragma unroll
    for (int a = 0; a < 2; ++a)
#pragma unroll
        for (int b = 0; b < 2; ++b)
#pragma unroll
            for (int m = 0; m < 4; ++m)
#pragma unroll
                for (int n = 0; n < 2; ++n) acc[a][b][m][n] = (f32x4){0.f, 0.f, 0.f, 0.f};
    bf16x8 At[4][2], B0[2][2], B1[2][2];
    const char* cA = (const char*)g.A + (size_t)cur.pm * tstep; const char* cB = (const char*)g.Bt + (size_t)cur.pn * tstep;
    S.a_ready(cur);
    if constexpr (SP2) {
        PG8_STAGE(PG8_SB(0, 0), cB, voffB); PG8_STAGE(PG8_SB(0, 1), cB + hstep, voffB); PG8_STAGE(PG8_SA(0, 0), cA, voffA); PG8_STAGE(PG8_SA(0, 1), cA + hstep, voffA);
        if (wr == 1) PG8_BAR;
        PG8_WAIT_V(2); PG8_BAR;
        PG8_STAGE(PG8_SB(1, 0), cB + kstep, voffB); PG8_STAGE(PG8_SA(1, 0), cA + kstep, voffA); PG8_STAGE(PG8_SB(1, 1), cB + hstep + kstep, voffB);
        PG8_WAIT_V(6); PG8_BAR;
    } else {
        PG8_STAGE(PG8_SB(0, 0), cB, voffB); PG8_STAGE(PG8_SA(0, 0), cA, voffA); PG8_STAGE(PG8_SB(0, 1), cB + hstep, voffB); PG8_STAGE(PG8_SA(0, 1), cA + hstep, voffA);
        if (wr == 1) PG8_BAR;
        PG8_WAIT_V(4); PG8_BAR;
        PG8_STAGE(PG8_SB(1, 0), cB + kstep, voffB); PG8_STAGE(PG8_SA(1, 0), cA + kstep, voffA); PG8_STAGE(PG8_SB(1, 1), cB + hstep + kstep, voffB);
        PG8_WAIT_V(6); PG8_BAR;
    }
    for (;;) {
        const bool has_next = S.next(ui + 1, nxt);
        const char* nA = has_next ? (const char*)g.A + (size_t)nxt.pm * tstep : cA; const char* nB = has_next ? (const char*)g.Bt + (size_t)nxt.pn * tstep : cB;
        for (int t = 0; t < nt; t += 2) {
            const bool last = (t == nt - 2);
            const char* a1 = cA + (size_t)(t + 1) * kstep;
            const char* a2 = last ? nA : cA + (size_t)(t + 2) * kstep; const char* b2 = last ? nB : cB + (size_t)(t + 2) * kstep;
            const char* a3 = a2 + kstep; const char* b3 = b2 + kstep;
            if (last && has_next) S.a_ready(nxt);
            if constexpr (SP2) {
            PG8_LDB(B0, 0, 0); PG8_LDB(B1, 0, 1); PG8_SCHED; PG8_LDA(At, 0, 0); PG8_STAGE(PG8_SA(1, 1), a1 + hstep, voffA);
            PG8_WAIT_V(8); PG8_WAIT_L(0); PG8_BAR; PG8_MMA(0, 0, At, B0); PG8_MMA(0, 1, At, B1); PG8_BAR; PG8_SCHED;
            PG8_LDA(At, 0, 1); PG8_STAGE(PG8_SB(0, 0), b2, voffB); PG8_STAGE(PG8_SB(0, 1), b2 + hstep, voffB); PG8_STAGE(PG8_SA(0, 0), a2, voffA);
            PG8_WAIT_V(8); PG8_WAIT_L(0); PG8_BAR; PG8_MMA(1, 0, At, B0); PG8_MMA(1, 1, At, B1); PG8_BAR; PG8_SCHED;
            PG8_LDB(B0, 1, 0); PG8_LDB(B1, 1, 1); PG8_SCHED; PG8_LDA(At, 1, 0); PG8_STAGE(PG8_SA(0, 1), a2 + hstep, voffA);
            PG8_WAIT_V(8); PG8_WAIT_L(0); PG8_BAR; PG8_MMA(0, 0, At, B0); PG8_MMA(0, 1, At, B1); PG8_BAR; PG8_SCHED;
            PG8_LDA(At, 1, 1); PG8_STAGE(PG8_SB(1, 0), b3, voffB); PG8_STAGE(PG8_SB(1, 1), b3 + hstep, voffB); PG8_STAGE(PG8_SA(1, 0), a3, voffA);
            PG8_WAIT_V(8); PG8_WAIT_L(0); PG8_BAR; PG8_MMA(1, 0, At, B0); PG8_MMA(1, 1, At, B1); PG8_BAR; PG8_SCHED;
            } else {
            PG8_LDB(B0, 0, 0); PG8_SCHED; PG8_LDA(At, 0, 0); PG8_STAGE(PG8_SA(1, 1), a1 + hstep, voffA);
            PG8_WAIT_L(8); PG8_BAR; PG8_WAIT_L(0); PG8_MMA(0, 0, At, B0); PG8_BAR; PG8_SCHED;
            PG8_LDB(B1, 0, 1); PG8_STAGE(PG8_SB(0, 0), b2, voffB);
            PG8_BAR; PG8_WAIT_L(0); PG8_MMA(0, 1, At, B1); PG8_BAR;
            PG8_LDA(At, 0, 1); PG8_STAGE(PG8_SA(0, 0), a2, voffA);
            PG8_BAR; PG8_WAIT_L(0); PG8_MMA(1, 0, At, B0); PG8_BAR; PG8_SCHED;
            PG8_STAGE(PG8_SB(0, 1), b2 + hstep, voffB);
            PG8_WAIT_V(6); PG8_BAR; PG8_MMA(1, 1, At, B1); PG8_BAR;
            PG8_LDB(B0, 1, 0); PG8_SCHED; PG8_LDA(At, 1, 0); PG8_STAGE(PG8_SA(0, 1), a2 + hstep, voffA);
            PG8_WAIT_L(8); PG8_BAR; PG8_WAIT_L(0); PG8_MMA(0, 0, At, B0); PG8_BAR; PG8_SCHED;
            PG8_LDB(B1, 1, 1); PG8_STAGE(PG8_SB(1, 0), b3, voffB);
            PG8_BAR; PG8_WAIT_L(0); PG8_MMA(0, 1, At, B1); PG8_BAR;
            PG8_LDA(At, 1, 1); PG8_STAGE(PG8_SA(1, 0), a3, voffA);
            PG8_BAR; PG8_WAIT_L(0); PG8_MMA(1, 0, At, B0); PG8_BAR; PG8_SCHED;
            PG8_STAGE(PG8_SB(1, 1), b3 + hstep, voffB);
            PG8_WAIT_V(6); PG8_BAR; PG8_MMA(1, 1, At, B1); PG8_BAR;
            }
        }
        if constexpr (ALIGN_EPI) { if (wr == 0) PG8_BAR; }
        if constexpr (!Epi::AFTER_DRAIN) { E(acc, cur, wr, wc, fr, fq); S.done(cur); }
        if (!has_next) break;
#pragma unroll
        for (int a = 0; a < 2; ++a)
#pragma unroll
            for (int b = 0; b < 2; ++b)
#pragma unroll
                for (int m = 0; m < 4; ++m)
#pragma unroll
                    for (int n = 0; n < 2; ++n) acc[a][b][m][n] = (f32x4){0.f, 0.f, 0.f, 0.f};
        cur = nxt; cA = nA; cB = nB; ++ui;
        if constexpr (ALIGN_EPI) { if (wr == 1) PG8_BAR; }
    }
    PG8_WAIT_V(0);
    if constexpr (!ALIGN_EPI) { if (wr == 0) PG8_BAR; }
    PG8_BAR;
    if constexpr (Epi::AFTER_DRAIN) { E.fused(acc, cur, wr, wc, fr, fq, lds, wid, lane); S.done(cur); }
#undef PG8_SA
#undef PG8_SB
#undef PG8_STAGE
#undef PG8_LDA
#undef PG8_LDB
#undef PG8_MMA
#undef PG8_WAIT_V
#undef PG8_WAIT_L
#undef PG8_BAR
#undef PG8_SCHED
}
}
#define DI __device__ __forceinline__
typedef unsigned short bf16_t;
typedef short bf16x8 __attribute__((ext_vector_type(8)));
typedef short s16x4 __attribute__((ext_vector_type(4)));
typedef float f32x16 __attribute__((ext_vector_type(16)));
typedef float f32x4 __attribute__((ext_vector_type(4)));
typedef unsigned u32x4 __attribute__((ext_vector_type(4)));
typedef unsigned u32x2 __attribute__((ext_vector_type(2)));
constexpr int NB = 16, T = 2048, D = 1024, M = NB * T, FF = 4096, DEPTH = 2;
constexpr int NU = 3584;
constexpr int DIN = 3592;
constexpr float EPS = 1e-6f;
constexpr int U_MQ = 0, U_MK = 256, U_MV = 512, U_MO = 768, U_AQ = 1024, U_AK = 1536, U_AV = 2048, U_HQ = 2560, U_HF = 2816, U_HI = 3072, U_HG = 3328;
constexpr float LOG2E = 1.4426950408889634f;
constexpr size_t MiB = 1u << 20;
constexpr size_t WS_CTL = 0, CTL_BYTES = 65536;
constexpr size_t WS_ROPE = 1 * MiB;
constexpr size_t WS_SS = 2 * MiB;
constexpr size_t WS_GATE = 3 * MiB;
constexpr size_t WS_WG = 4 * MiB;
constexpr size_t WS_LB = 4 * MiB + 512 * 1024;
constexpr size_t WS_PAR = 4 * MiB + 768 * 1024;
constexpr int PAR_GB = 0, PAR_MN = 64, PAR_QN = 192, PAR_KN = 320, PAR_LAM = 448, PAR_SUB = 960, PAR_HN = 1216, PAR_CW = 1344, PAR_N = 5440, PAR_LAMV = 5440;
constexpr size_t WS_W = 5 * MiB;
constexpr size_t W_LAYER = 25 * MiB, W_IN = 0, W_OUT = 7 * MiB, W_UP = 9 * MiB, W_DN = 17 * MiB;
constexpr size_t WS_XB = 56 * MiB;
constexpr size_t WS_U = 120 * MiB;
constexpr size_t WS_MIX = 344 * MiB;
constexpr size_t WS_H = 120 * MiB;
constexpr size_t WS_END = 408 * MiB;
constexpr int LDS_BYTES = 147456;
constexpr int NTHREADS = 512;

DI unsigned f2bf(float f) { unsigned u = __builtin_bit_cast(unsigned, f); return (u + 0x7fffu + ((u >> 16) & 1u)) >> 16; }
DI float bf2f(unsigned short b) { return __builtin_bit_cast(float, (unsigned)b << 16); }
typedef float f32x2_t __attribute__((ext_vector_type(2))); typedef __bf16 bf16x2_t __attribute__((ext_vector_type(2)));
DI unsigned cvtpk(float lo, float hi) { f32x2_t v = {lo, hi}; bf16x2_t b = __builtin_convertvector(v, bf16x2_t); return __builtin_bit_cast(unsigned, b); }
DI bf16x8 pack8(const f32x16& x, int s) { u32x4 p; p.x = cvtpk(x[8 * s], x[8 * s + 1]); p.y = cvtpk(x[8 * s + 2], x[8 * s + 3]); p.z = cvtpk(x[8 * s + 4], x[8 * s + 5]); p.w = cvtpk(x[8 * s + 6], x[8 * s + 7]); return __builtin_bit_cast(bf16x8, p); }
DI int crow(int reg, int h) { return (reg & 3) + 8 * (reg >> 2) + 4 * h; }
#define MFMA32(a, b, c) __builtin_amdgcn_mfma_f32_32x32x16_bf16((a), (b), (c), 0, 0, 0)
DI bf16x8 ld8(const bf16_t* p) { return *(const bf16x8*)p; }
DI bf16x8 ld_perm(const bf16_t* p, int h) { const s16x4 lo = *(const s16x4*)(p + 4 * h), hi = *(const s16x4*)(p + 8 + 4 * h); return __builtin_shufflevector(lo, hi, 0, 1, 2, 3, 4, 5, 6, 7); }
DI void lds_barrier() { asm volatile("s_waitcnt lgkmcnt(0)" ::: "memory"); __builtin_amdgcn_s_barrier(); asm volatile("" ::: "memory"); }
DI float sigmoidf_(float x) { return __builtin_amdgcn_rcpf(1.f + __expf(-x)); }
DI float wave_sum(float v) {
#pragma unroll
    for (int o = 1; o < 64; o <<= 1) v += __shfl_xor(v, o);
    return v;
}
DI void unpack8(const u32x4& w, float* f) {
    f[0] = __builtin_bit_cast(float, w.x << 16); f[1] = __builtin_bit_cast(float, w.x & 0xffff0000u);
    f[2] = __builtin_bit_cast(float, w.y << 16); f[3] = __builtin_bit_cast(float, w.y & 0xffff0000u);
    f[4] = __builtin_bit_cast(float, w.z << 16); f[5] = __builtin_bit_cast(float, w.z & 0xffff0000u);
    f[6] = __builtin_bit_cast(float, w.w << 16); f[7] = __builtin_bit_cast(float, w.w & 0xffff0000u);
}
DI u32x4 pack8f(const float* f) { u32x4 w; w.x = cvtpk(f[0], f[1]); w.y = cvtpk(f[2], f[3]); w.z = cvtpk(f[4], f[5]); w.w = cvtpk(f[6], f[7]); return w; }

struct Params {
    const float* x; const float* norm1_g; const float* w_in; const float* conv_w; const float* gate_b; const float* mnorm_g;
    const float* qn_g; const float* kn_g; const float* lam; const float* subln_g; const float* lb_param; const float* hnorm_g;
    const float* w_out; const float* norm2_g; const float* w_up; const float* w_down;
    float* out; unsigned char* ws; int ph_lo, ph_hi;
};

struct TDesc { const float* W; bf16_t* WT; const float* g; int K, Nsrc, skip_from, skip, k0, n0, wide; };
DI TDesc tt_decode(const Params& P, int it) {
    constexpr int T_IN = (D / 64) * (NU / 256), T_OUT = (D / 64) * (D / 256), T_UP = (D / 64) * (FF / 256), T_DN = (FF / 64) * (D / 256), T_L = T_IN + T_OUT + T_UP + T_DN;
    const int l = it / T_L; int r = it % T_L; unsigned char* wb = P.ws + WS_W + (size_t)l * W_LAYER; TDesc d;
    if (r < T_IN) { d.W = P.w_in + (size_t)l * D * DIN; d.WT = (bf16_t*)(wb + W_IN); d.g = P.norm1_g + l * D; d.K = D; d.Nsrc = DIN; d.skip_from = 1024; d.skip = 8; d.k0 = (r / (NU / 256)) * 64; d.n0 = (r % (NU / 256)) * 256; d.wide = 1; return d; } r -= T_IN;
    if (r < T_OUT) { d.W = P.w_out + (size_t)l * D * D; d.WT = (bf16_t*)(wb + W_OUT); d.g = nullptr; d.K = D; d.Nsrc = D; d.skip_from = 1 << 30; d.skip = 0; d.k0 = (r / (D / 256)) * 64; d.n0 = (r % (D / 256)) * 256; d.wide = 0; return d; } r -= T_OUT;
    if (r < T_UP) { d.W = P.w_up + (size_t)l * D * FF; d.WT = (bf16_t*)(wb + W_UP); d.g = P.norm2_g + l * D; d.K = D; d.Nsrc = FF; d.skip_from = 1 << 30; d.skip = 0; d.k0 = (r / (FF / 256)) * 64; d.n0 = (r % (FF / 256)) * 256; d.wide = 0; return d; } r -= T_UP;
    d.W = P.w_down + (size_t)l * FF * D; d.WT = (bf16_t*)(wb + W_DN); d.g = nullptr; d.K = FF; d.Nsrc = D; d.skip_from = 1 << 30; d.skip = 0; d.k0 = (r / (D / 256)) * 64; d.n0 = (r % (D / 256)) * 256; d.wide = 0; return d;
}
DI void tt_load(const TDesc& d, float (&v)[32], int tid) {
    const int c = tid & 255, rr = tid >> 8;
    const int cl = d.wide ? (64 * ((c >> 5) & 3) + 32 * (c >> 7) + (c & 31)) : c;
    const int nsrc = d.n0 + cl + ((d.n0 + cl) >= d.skip_from ? d.skip : 0);
#pragma unroll
    for (int i = 0; i < 32; ++i) v[i] = d.W[(size_t)(d.k0 + rr + 2 * i) * d.Nsrc + nsrc];
}
DI void tt_finish(const TDesc& d, float (&v)[32], float* scr, int tid) {
    const int c = tid & 255, rr = tid >> 8;
    if (d.g) {
#pragma unroll
        for (int i = 0; i < 32; ++i) v[i] *= d.g[d.k0 + rr + 2 * i]; }
#pragma unroll
    for (int i = 0; i < 32; ++i) scr[c * 65 + rr + 2 * i] = v[i];
    __syncthreads();
#pragma unroll
    for (int i = 0; i < 4; ++i) { const int id = tid + 512 * i, n = id >> 3, kc = (id & 7) * 8;
        float f[8];
#pragma unroll
        for (int j = 0; j < 8; ++j) f[j] = scr[n * 65 + kc + j];
        *(u32x4*)(d.WT + (size_t)(d.n0 + n) * d.K + d.k0 + kc) = pack8f(f); }
    __syncthreads();
}
DI void p0_prep(const Params& P, unsigned char* lds, int tid_in) {
    float* scr = (float*)lds; int tid = tid_in; asm volatile("" : "+v"(tid));
    constexpr int T_IN = (D / 64) * (NU / 256), T_OUT = (D / 64) * (D / 256), T_UP = (D / 64) * (FF / 256), T_DN = (FF / 64) * (D / 256), T_L = T_IN + T_OUT + T_UP + T_DN;
    {
        int it = blockIdx.x;
        if (it < DEPTH * T_L) {
            TDesc d = tt_decode(P, it); float v[32]; tt_load(d, v, tid);
            for (;;) {
                const int itn = it + gridDim.x; const bool more = itn < DEPTH * T_L;
                TDesc dn = d; float vn[32];
                if (more) { dn = tt_decode(P, itn); tt_load(dn, vn, tid); }
                tt_finish(d, v, scr, tid);
                if (!more) break;
                d = dn; it = itn;
#pragma unroll
                for (int i = 0; i < 32; ++i) v[i] = vn[i];
            }
        }
    }
    const int gt = blockIdx.x * NTHREADS + tid, NT_ = gridDim.x * NTHREADS;
    float* WG = (float*)(P.ws + WS_WG);
    for (int i = gt; i < DEPTH * 8 * D; i += NT_) { const int l = i / (8 * D), j = (i / D) % 8, k = i % D; WG[i] = P.norm1_g[l * D + k] * P.w_in[(size_t)l * D * DIN + (size_t)k * DIN + 1024 + j]; }
    { float* PR = (float*)(P.ws + WS_PAR);
      for (int i = gt; i < PAR_N; i += NT_) { float v;
        if (i < PAR_MN) v = (i < 16) ? P.gate_b[i] : 0.f; else if (i < PAR_QN) v = P.mnorm_g[i - PAR_MN]; else if (i < PAR_KN) v = P.qn_g[i - PAR_QN]; else if (i < PAR_LAM) v = P.kn_g[i - PAR_KN];
        else if (i < PAR_SUB) v = P.lam[i - PAR_LAM]; else if (i < PAR_HN) v = P.subln_g[i - PAR_SUB]; else if (i < PAR_CW) v = P.hnorm_g[i - PAR_HN]; else v = P.conv_w[i - PAR_CW];
        PR[i] = v; } }
    { float* SS = (float*)(P.ws + WS_SS); for (int i = gt; i < 3 * M; i += NT_) SS[M + i] = 0.f; }
    if (blockIdx.x == 0 && tid < 64) {
        for (int l = 0; l < DEPTH; ++l) { const float* lv = P.lam + l * 256; const float s1 = wave_sum(lv[tid] * lv[64 + tid]), s2 = wave_sum(lv[128 + tid] * lv[192 + tid]);
            const float lam_init = (l == 0) ? 0.2f : 0.35550906759096926f;
            if (tid == 0) ((float*)(P.ws + WS_PAR))[PAR_LAMV + l] = __expf(s1) - __expf(s2) + lam_init; } }
    float* LB = (float*)(P.ws + WS_LB);
    for (int i = gt; i < 256; i += NT_) { const float a = P.lb_param[i], b = P.lb_param[256 + i]; const float mx = fmaxf(a, b); const float ea = __expf(a - mx), eb = __expf(b - mx); LB[i] = 0.f; LB[256 + i] = eb / (ea + eb); }
    float* RP = (float*)(P.ws + WS_ROPE);
    for (int i = gt; i < T * 8; i += NT_) {
        const int pos = i >> 3, fi = i & 7;
        const float inv = fi == 0 ? 1.0f : fi == 1 ? 0.1939227432012558f : fi == 2 ? 0.03760603070259094f : fi == 3 ? 0.007292664609849453f : fi == 4 ? 0.0014142135623842478f
                        : fi == 5 ? 0.00027424818836152554f : fi == 6 ? 5.318296098266728e-05f : 1.0313386155758053e-05f;
        const float af = (float)pos * inv; const double xx = (double)af;
        const double kq = __builtin_rint(xx * 0.63661977236758134308); const double r = (xx - kq * 1.57079632679489661923) ; const double r2 = r * r;
        const double sn = r * (1.0 + r2 * (-1.0 / 6 + r2 * (1.0 / 120 + r2 * (-1.0 / 5040 + r2 * (1.0 / 362880 + r2 * (-1.0 / 39916800 + r2 * (1.0 / 6227020800.0)))))));
        const double cs = 1.0 + r2 * (-0.5 + r2 * (1.0 / 24 + r2 * (-1.0 / 720 + r2 * (1.0 / 40320 + r2 * (-1.0 / 3628800 + r2 * (1.0 / 479001600.0))))));
        const int qd = ((int)kq) & 3;
        const double s_ = (qd == 0) ? sn : (qd == 1) ? cs : (qd == 2) ? -sn : -cs;
        const double c_ = (qd == 0) ? cs : (qd == 1) ? -sn : (qd == 2) ? -cs : sn;
        RP[2 * i] = (float)c_; RP[2 * i + 1] = (float)s_;
    }
}

DI void row_prep(const float* X, bf16_t* XB, float* SS, const float* w_in0, const float* g1, const float* gb, float* GATE, float* wlds, int tid) {
    for (int k = tid; k < D; k += NTHREADS) { const f32x4 a = *(const f32x4*)(w_in0 + (size_t)k * DIN + 1024), c = *(const f32x4*)(w_in0 + (size_t)k * DIN + 1028); const float g = g1[k];
        wlds[0 * D + k] = a.x * g; wlds[1 * D + k] = a.y * g; wlds[2 * D + k] = a.z * g; wlds[3 * D + k] = a.w * g; wlds[4 * D + k] = c.x * g; wlds[5 * D + k] = c.y * g; wlds[6 * D + k] = c.z * g; wlds[7 * D + k] = c.w * g; }
    __syncthreads();
    const int lane = tid & 63, wv = tid >> 6; const int gw = blockIdx.x * 8 + wv, NGW = gridDim.x * 8;
    for (int m = gw; m < M; m += 2 * NGW) {
        const int m2 = m + NGW;
        const f32x4* xr = (const f32x4*)(X + (size_t)m * D) + lane; const f32x4* xr2 = (const f32x4*)(X + (size_t)(m2 < M ? m2 : m) * D) + lane;
        f32x4 v[4], v2[4]; float s = 0.f, s2 = 0.f;
#pragma unroll
        for (int j = 0; j < 4; ++j) { v[j] = xr[64 * j]; v2[j] = xr2[64 * j]; }
#pragma unroll
        for (int j = 0; j < 4; ++j) { s += (v[j].x * v[j].x + v[j].y * v[j].y) + (v[j].z * v[j].z + v[j].w * v[j].w); s2 += (v2[j].x * v2[j].x + v2[j].y * v2[j].y) + (v2[j].z * v2[j].z + v2[j].w * v2[j].w); }
        s = wave_sum(s); s2 = wave_sum(s2);
        u32x2* o8 = (u32x2*)(XB + (size_t)m * D) + lane;
#pragma unroll
        for (int j = 0; j < 4; ++j) { u32x2 w; w.x = cvtpk(v[j].x, v[j].y); w.y = cvtpk(v[j].z, v[j].w); o8[64 * j] = w; }
        if (lane == 0) SS[m] = s;
        if (m2 < M) { u32x2* o82 = (u32x2*)(XB + (size_t)m2 * D) + lane;
#pragma unroll
            for (int j = 0; j < 4; ++j) { u32x2 w; w.x = cvtpk(v2[j].x, v2[j].y); w.y = cvtpk(v2[j].z, v2[j].w); o82[64 * j] = w; }
            if (lane == 0) SS[m2] = s2; }
        float g1v = 0.f, g2v = 0.f;
#pragma unroll
        for (int g = 0; g < 8; ++g) { float a = 0.f, a2 = 0.f;
#pragma unroll
            for (int j = 0; j < 4; ++j) { const f32x4 w = *(const f32x4*)(wlds + g * D + 256 * j + 4 * lane);
                a += (v[j].x * w.x + v[j].y * w.y) + (v[j].z * w.z + v[j].w * w.w); a2 += (v2[j].x * w.x + v2[j].y * w.y) + (v2[j].z * w.z + v2[j].w * w.w); }
            a = wave_sum(a); a2 = wave_sum(a2); g1v = (lane == g) ? a : g1v; g2v = (lane == g) ? a2 : g2v; }
        if (lane < 8) { GATE[(size_t)m * 8 + lane] = g1v * __builtin_amdgcn_rsqf(s * (1.0f / D) + EPS) + gb[lane];
            if (m2 < M) GATE[(size_t)m2 * 8 + lane] = g2v * __builtin_amdgcn_rsqf(s2 * (1.0f / D) + EPS) + gb[lane]; }
    }
    __syncthreads();
}
DI void gates_prep(const bf16_t* XB, const float* SS, const float* WG, const float* gb, float* GATE, float* wlds, int tid) {
    bf16_t* wb = (bf16_t*)wlds;
    for (int i = tid; i < 8 * D / 8; i += NTHREADS) { const f32x4 a = ((const f32x4*)WG)[2 * i], c = ((const f32x4*)WG)[2 * i + 1]; const float t8[8] = {a.x, a.y, a.z, a.w, c.x, c.y, c.z, c.w}; ((u32x4*)wb)[i] = pack8f(t8); }
    __syncthreads();
    const int lane = tid & 63, r = lane & 31, h = lane >> 5, wv = tid >> 6;
    for (int blk = blockIdx.x * 8 + wv; blk < M / 32; blk += gridDim.x * 8) {
        const int m0 = blk * 32;
        const bf16_t* xr = XB + (size_t)(m0 + r) * D + 8 * h;
        f32x16 acc;
#pragma unroll
        for (int e = 0; e < 16; ++e) acc[e] = 0.f;
#pragma unroll 8
        for (int ks = 0; ks < D / 16; ++ks) {
            const bf16x8 a = *(const bf16x8*)(xr + 16 * ks);
            bf16x8 bfr = {0, 0, 0, 0, 0, 0, 0, 0};
            if (r < 8) bfr = *(const bf16x8*)(wb + r * D + 16 * ks + 8 * h);
            acc = MFMA32(a, bfr, acc);
        }
        if (r < 8) { const float bias = gb[r];
#pragma unroll
            for (int e = 0; e < 16; ++e) { const int m = m0 + crow(e, h); GATE[(size_t)m * 8 + r] = acc[e] * __builtin_amdgcn_rsqf(SS[m] * (1.0f / D) + EPS) + bias; } }
    }
    __syncthreads();
}

DI void attn_qk_prep(bf16_t* U, const float* qg, const float* kg, const float* RP, int tid, bf16_t* DST = nullptr) {
    const int sub = tid & 7, grp = (tid >> 3) & 15, rib = tid >> 7;
    float gg[8];
#pragma unroll
    for (int j = 0; j < 8; ++j) gg[j] = ((grp < 8) ? qg : kg)[sub * 8 + j];
    for (int m0 = blockIdx.x * 32 + rib; m0 < M; m0 += gridDim.x * 32) {
        u32x4 w[8];
#pragma unroll
        for (int i = 0; i < 8; ++i) w[i] = *(const u32x4*)(U + (size_t)(m0 + 4 * i) * NU + U_AQ + grp * 64 + sub * 8);
#pragma unroll
        for (int i = 0; i < 8; ++i) {
            const int m = m0 + 4 * i; float f[8]; unpack8(w[i], f);
            float ss = 0.f;
#pragma unroll
            for (int j = 0; j < 8; ++j) ss += f[j] * f[j];
            ss += __shfl_xor(ss, 1); ss += __shfl_xor(ss, 2); ss += __shfl_xor(ss, 4);
            const float rstd = __builtin_amdgcn_rsqf(ss * (1.f / 64) + EPS);
#pragma unroll
            for (int j = 0; j < 8; ++j) f[j] = f[j] * rstd * gg[j];
            const int pos = m & (T - 1);
            float oth[8];
#pragma unroll
            for (int j = 0; j < 8; ++j) oth[j] = __shfl_xor(f[j], 1);
            if (sub < 2) {
                const float* rp = RP + (size_t)pos * 16;
#pragma unroll
                for (int j = 0; j < 8; ++j) { const float c = rp[2 * j], s = rp[2 * j + 1]; f[j] = (sub == 0) ? (f[j] * c - oth[j] * s) : (f[j] * c + oth[j] * s); }
            }
            if (grp < 8) {
#pragma unroll
                for (int j = 0; j < 8; ++j) f[j] *= 0.125f * LOG2E;
            }
            if (DST) *(u32x4*)(DST + (size_t)m * D + grp * 64 + sub * 8) = pack8f(f); else *(u32x4*)(U + (size_t)m * NU + U_AQ + grp * 64 + sub * 8) = pack8f(f);
        }
    }
}
typedef short v4i16_t __attribute__((ext_vector_type(4)));
typedef __attribute__((address_space(3))) const unsigned char* lds_cp;
DI s16x4 tr_rd(lds_cp p) { return __builtin_bit_cast(s16x4, __builtin_amdgcn_ds_read_tr16_b64_v4i16((__attribute__((address_space(3))) v4i16_t*)p)); }
template <bool PERMK> DI bf16x8 tr_frag(lds_cp img, int pitchB, int k0, int m0, int lane) {
    const int h = lane >> 5, q = (lane & 15) >> 2, p = lane & 3, blk = (lane >> 4) & 1;
    const int kl = PERMK ? (k0 + 4 * h + q) : (k0 + 8 * h + q), kh = PERMK ? (kl + 8) : (kl + 4);
    const int cb = (m0 + 16 * blk + 4 * p) * 2;
    const s16x4 lo = tr_rd(img + kl * pitchB + cb), hi = tr_rd(img + kh * pitchB + cb);
    return __builtin_shufflevector(lo, hi, 0, 1, 2, 3, 4, 5, 6, 7);
}
constexpr int AT_KB = 18432, AT_VB = 18432, AT_BUF = AT_KB + AT_VB;
constexpr int AT_OX = 0, AT_OS = 2 * AT_BUF;
DI void attn_unit(const bf16_t* U, bf16_t* MIX, int b, int hd, int qb, float lam, float osc, const float* subg, unsigned char* lds, int tid_in) {
    int tid = tid_in; asm volatile("" : "+v"(tid));
    const int lane = tid & 63, r = lane & 31, h = lane >> 5, w = __builtin_amdgcn_readfirstlane(tid >> 6), c = w >> 2, wq = w & 3;
    float* OX = (float*)(lds + AT_OX); bf16_t* OS = (bf16_t*)(lds + AT_OS);
    const lds_cp lds3 = (lds_cp)lds;
    const size_t rowbase = (size_t)b * T; const int q0 = qb * 128; const int NT = 2 * qb + 2;
    bf16x8 qf[4];
    { const bf16_t* qp = U + (rowbase + q0 + 32 * wq + r) * NU + U_AQ + hd * 128 + c * 64 + 8 * h;
#pragma unroll
      for (int ks = 0; ks < 4; ++ks) qf[ks] = ld8(qp + 16 * ks); }
    u32x4 kreg[2], vreg[2];
#define AT_PREFETCH(kt) do { _Pragma("unroll") for (int i_ = 0; i_ < 2; ++i_) { const int id_ = tid + 512 * i_, key_ = id_ >> 4, ch_ = id_ & 15; \
        const bf16_t* rp_ = U + (rowbase + 64 * (kt) + key_) * NU + hd * 128 + ch_ * 8; kreg[i_] = *(const u32x4*)(rp_ + U_AK); vreg[i_] = *(const u32x4*)(rp_ + U_AV); } } while (0)
#define AT_STORE(buf) do { unsigned char* kb_ = lds + (buf) * AT_BUF; _Pragma("unroll") for (int i_ = 0; i_ < 2; ++i_) { const int id_ = tid + 512 * i_, key_ = id_ >> 4, ch_ = id_ & 15; \
        *(u32x4*)(kb_ + (((ch_ >> 3) * 64 + key_) * 72 + (ch_ & 7) * 8) * 2) = kreg[i_]; *(u32x4*)(kb_ + AT_KB + (key_ * 144 + ch_ * 8) * 2) = vreg[i_]; } } while (0)
    AT_PREFETCH(0);
    __syncthreads();
    AT_STORE(0);
    if (NT > 1) AT_PREFETCH(1);
    float m_ref = 0.f, l_run = 0.f; f32x16 o[4]; f32x16 negm;
#pragma unroll
    for (int e = 0; e < 16; ++e) negm[e] = 0.f;
#pragma unroll
    for (int vb = 0; vb < 4; ++vb)
#pragma unroll
        for (int e = 0; e < 16; ++e) o[vb][e] = 0.f;
    const int qpos = q0 + 32 * wq + r;
    __syncthreads();
    if (w >= 4) __builtin_amdgcn_s_setprio(1);
    for (int kt = 0; kt < NT; ++kt) {
        const int cur = kt & 1;
        if (kt + 1 < NT) { AT_STORE(cur ^ 1); if (kt + 2 < NT) AT_PREFETCH(kt + 2); }
        const bf16_t* KS = (const bf16_t*)(lds + cur * AT_BUF); const lds_cp VS = lds3 + cur * AT_BUF + AT_KB;
        if (kt != NT - 1 || wq >= 2) {
        f32x16 st[2];
        {
            bf16x8 kf[2][4];
#pragma unroll
            for (int nb = 0; nb < 2; ++nb)
#pragma unroll
                for (int ks = 0; ks < 4; ++ks) kf[nb][ks] = ld8(KS + (c * 64 + 32 * nb + r) * 72 + 16 * ks + 8 * h);
            __builtin_amdgcn_sched_barrier(0);
#pragma unroll
            for (int nb = 0; nb < 2; ++nb) {
                st[nb] = MFMA32(kf[nb][0], qf[0], negm);
#pragma unroll
                for (int ks = 1; ks < 4; ++ks) st[nb] = MFMA32(kf[nb][ks], qf[ks], st[nb]); }
        }
        if (kt >= 2 * qb) {
            asm volatile("" ::: "memory");
#pragma unroll
            for (int nb = 0; nb < 2; ++nb)
#pragma unroll
                for (int e = 0; e < 16; ++e) { const int key = 64 * kt + 32 * nb + crow(e, h); if (key > qpos) st[nb][e] = -1e30f; } }
        float mx = st[0][0];
#pragma unroll
        for (int nb = 0; nb < 2; ++nb)
#pragma unroll
            for (int e = 0; e < 16; ++e) mx = fmaxf(mx, st[nb][e]);
        { const auto rr_ = __builtin_amdgcn_permlane32_swap(__float_as_uint(mx), __float_as_uint(mx), false, false); mx = fmaxf(__uint_as_float(rr_[0]), __uint_as_float(rr_[1])); }
        if (kt == 0 || __any(mx > 8.0f)) {
            const float delta = (kt == 0) ? mx : fmaxf(mx, 0.f); const float alpha = __builtin_amdgcn_exp2f(-delta); m_ref += delta; l_run *= alpha;
#pragma unroll
            for (int nb = 0; nb < 2; ++nb)
#pragma unroll
                for (int e = 0; e < 16; ++e) st[nb][e] -= delta;
#pragma unroll
            for (int e = 0; e < 16; ++e) negm[e] = -m_ref;
#pragma unroll
            for (int vb = 0; vb < 4; ++vb)
#pragma unroll
                for (int e = 0; e < 16; ++e) o[vb][e] *= alpha;
        }
        f32x2_t ps2 = {0.f, 0.f};
#pragma unroll
        for (int e = 0; e < 16; e += 2) { const float p0 = __builtin_amdgcn_exp2f(st[0][e]), p1 = __builtin_amdgcn_exp2f(st[0][e + 1]); st[0][e] = p0; st[0][e + 1] = p1; ps2 += (f32x2_t){p0, p1}; }
        {
            bf16x8 va[8], vn[8];
#pragma unroll
            for (int i = 0; i < 8; ++i) va[i] = tr_frag<true>(VS, 288, 16 * (i >> 2), 32 * (i & 3), lane);
            const bf16x8 pfa = pack8(st[0], 0), pfb = pack8(st[0], 1);
            __builtin_amdgcn_sched_barrier(0);
#pragma unroll
            for (int i = 0; i < 8; ++i) {
                o[i & 3] = MFMA32(va[i], (i < 4) ? pfa : pfb, o[i & 3]);
                vn[i] = tr_frag<true>(VS, 288, 32 + 16 * (i >> 2), 32 * (i & 3), lane);
                { const int e2 = 2 * i; const float p0 = __builtin_amdgcn_exp2f(st[1][e2]), p1 = __builtin_amdgcn_exp2f(st[1][e2 + 1]); st[1][e2] = p0; st[1][e2 + 1] = p1; ps2 += (f32x2_t){p0, p1}; }
                __builtin_amdgcn_sched_barrier(0);
            }
            l_run += ps2.x + ps2.y;
            const bf16x8 pfc = pack8(st[1], 0), pfd = pack8(st[1], 1);
            __builtin_amdgcn_sched_barrier(0);
#pragma unroll
            for (int i = 0; i < 8; ++i) o[i & 3] = MFMA32(vn[i], (i < 4) ? pfc : pfd, o[i & 3]);
        }
        }
        lds_barrier();
    }
#undef AT_PREFETCH
#undef AT_STORE
    __builtin_amdgcn_s_setprio(0);
    const float l_tot = l_run + __shfl_xor(l_run, 32); const float inv_l = __builtin_amdgcn_rcpf(l_tot);
    if (c == 1) {
#pragma unroll
        for (int vb = 0; vb < 4; ++vb)
#pragma unroll
            for (int e = 0; e < 16; ++e) OX[(wq * 32 + r) * 129 + 32 * vb + crow(e, h)] = o[vb][e] * inv_l; }
    __syncthreads();
    if (c == 0) {
        float ss = 0.f;
#pragma unroll
        for (int vb = 0; vb < 4; ++vb)
#pragma unroll
            for (int e = 0; e < 16; ++e) { const float v = o[vb][e] * inv_l - lam * OX[(wq * 32 + r) * 129 + 32 * vb + crow(e, h)]; o[vb][e] = v; ss += v * v; }
        ss += __shfl_xor(ss, 32);
        const float rn = osc * __builtin_amdgcn_rsqf(ss * (1.f / 128) + EPS);
#pragma unroll
        for (int vb = 0; vb < 4; ++vb)
#pragma unroll
            for (int e = 0; e < 16; ++e) { const int v = 32 * vb + crow(e, h); OS[(wq * 32 + r) * 136 + v] = (bf16_t)f2bf(o[vb][e] * rn * subg[v]); }
    }
    __syncthreads();
    if (c == 0) {
#pragma unroll
        for (int i = 0; i < 8; ++i) { const int idx = i * 64 + lane, row = idx >> 4, ch = idx & 15;
            const u32x4 v = *(const u32x4*)(OS + (wq * 32 + row) * 136 + ch * 8);
            *(u32x4*)(MIX + (rowbase + q0 + 32 * wq + row) * D + 256 + hd * 128 + ch * 8) = v; }
    }
}
constexpr int ML_Q = 0, ML_K = 18432, ML_WK = 36864, ML_V = 55296, ML_C = 73728, ML_H = 82944, ML_AR = 116224, ML_N = 118272, ML_CW = 118528, ML_CF = 120576, ML_NG = 137216;
DI float logsigf_(float x) { return fminf(x, 0.f) - __logf(1.f + __expf(-fabsf(x))); }
DI void mlstm_unit(const bf16_t* U, const float* GATE, bf16_t* MIX, const float* convw, const float* ng, int b, int hd, unsigned char* lds, int tid_in) {
    int tid = tid_in; asm volatile("" : "+v"(tid));
    const int lane = tid & 63, r = lane & 31, h = lane >> 5, w = __builtin_amdgcn_readfirstlane(tid >> 6);
    bf16_t* Q = (bf16_t*)(lds + ML_Q); bf16_t* K = (bf16_t*)(lds + ML_K); bf16_t* WK = (bf16_t*)(lds + ML_WK); bf16_t* VV = (bf16_t*)(lds + ML_V);
    bf16_t* CL = (bf16_t*)(lds + ML_C); float* H = (float*)(lds + ML_H); float* AR = (float*)(lds + ML_AR); float* NV = (float*)(lds + ML_N); float* CW = (float*)(lds + ML_CW);
    float* rowt = AR; float* colt = AR + 128; float* scl = AR + 256; float* dfl = AR + 384;
    const lds_cp lds3 = (lds_cp)lds;
    const size_t rowbase = (size_t)b * T;
    __syncthreads();
    { const int j = tid >> 7, ch = tid & 127; CW[j * 128 + ch] = convw[j * 512 + (ch < 64 ? hd * 64 + ch : 256 + hd * 64 + (ch - 64))]; }
    float* NG = (float*)(lds + ML_NG);
    if (tid < 64) { NV[tid] = 0.f; NG[tid] = ng[tid]; }
    for (int i = tid; i < 64 * 72; i += NTHREADS) CL[i] = 0;
    float* CF = (float*)(lds + ML_CF);
    for (int i = tid; i < 64 * 65; i += NTHREADS) CF[i] = 0.f;
    float mprev = 0.f;
    const int cch = tid & 15, rblk = tid >> 4;
    const int ccol = (cch < 8) ? (U_MQ + hd * 64 + cch * 8) : (U_MK + hd * 64 + (cch - 8) * 8);
    const int ft = tid >> 2, fv0 = (tid & 3) * 16;
    u32x4 ncr[7]; float ngt[4];
#define ML_PREFETCH(c_) do { const int t0_ = 128 * (c_); \
        _Pragma("unroll") for (int j_ = 0; j_ < 7; ++j_) { const int tt_ = t0_ + 4 * rblk - 3 + j_; ncr[j_] = (tt_ >= 0) ? *(const u32x4*)(U + (rowbase + tt_) * NU + ccol) : (u32x4){0u, 0u, 0u, 0u}; } \
        { const float* gp_ = GATE + (rowbase + t0_ + 2 * lane) * 8; ngt[0] = gp_[hd]; ngt[1] = gp_[4 + hd]; ngt[2] = gp_[8 + hd]; ngt[3] = gp_[12 + hd]; } } while (0)
    ML_PREFETCH(0);
    for (int c = 0; c < T / 128; ++c) {
        const int t0 = 128 * c;
        u32x4 cr[7], vr[2], orw[2];
#pragma unroll
        for (int j = 0; j < 7; ++j) cr[j] = ncr[j];
#pragma unroll
        for (int i = 0; i < 2; ++i) { const int id = tid + 512 * i; vr[i] = *(const u32x4*)(U + (rowbase + t0 + (id >> 3)) * NU + U_MV + hd * 64 + (id & 7) * 8); }
        const float ig0 = ngt[0], fg0 = ngt[1], ig1 = ngt[2], fg1 = ngt[3];
        const float lf0 = logsigf_(fg0), lf1 = logsigf_(fg1);
        const float ps = lf0 + lf1; float incl = ps;
#pragma unroll
        for (int o = 1; o < 64; o <<= 1) { const float t_ = __shfl_up(incl, o); if (lane >= o) incl += t_; }
        const float b0 = incl - ps + lf0, b1 = incl;
        const float a0 = ig0 - b0, a1 = ig1 - b1;
        float cmi = fmaxf(a0, a1);
#pragma unroll
        for (int o = 1; o < 64; o <<= 1) { const float t_ = __shfl_up(cmi, o); if (lane >= o) cmi = fmaxf(cmi, t_); }
        float cme = __shfl_up(cmi, 1); if (lane == 0) cme = -3.0e38f;
        const float cm0 = fmaxf(cme, a0), cm1 = cmi;
        const float amax = __shfl(cmi, 63), bL = __shfl(incl, 63);
        const float M0 = fmaxf(cm0, mprev), M1 = fmaxf(cm1, mprev), Mx = fmaxf(mprev, amax);
        const float wv0 = __expf(a0 - Mx), wv1 = __expf(a1 - Mx);
        const float dec = __expf(mprev - Mx);
        if (w == 0) {
            rowt[2 * lane] = -M0 * LOG2E; rowt[2 * lane + 1] = -M1 * LOG2E;
            colt[2 * lane] = a0 * LOG2E; colt[2 * lane + 1] = a1 * LOG2E;
            scl[2 * lane] = __expf(mprev - M0); scl[2 * lane + 1] = __expf(mprev - M1);
            dfl[2 * lane] = __expf(-(b0 + M0)); dfl[2 * lane + 1] = __expf(-(b1 + M1));
        }
        mprev = bL + Mx;
        {
            const float w0 = __shfl(wv0, 2 * (rblk & 31)), w1 = __shfl(wv1, 2 * (rblk & 31)), w2 = __shfl(wv0, 2 * (rblk & 31) + 1), w3 = __shfl(wv1, 2 * (rblk & 31) + 1);
            const float wts[4] = {w0, w1, w2, w3};
            const float ksc = (cch < 8) ? 1.0f : 0.125f;
            u32x4 opk[4], wpk[4];
#pragma unroll
            for (int p = 0; p < 4; ++p) {
                float xl[7], xh[7], cl[4], chh[4];
#pragma unroll
                for (int j = 0; j < 7; ++j) { const unsigned wd = cr[j][p]; xl[j] = __builtin_bit_cast(float, wd << 16); xh[j] = __builtin_bit_cast(float, wd & 0xffff0000u); }
#pragma unroll
                for (int j = 0; j < 4; ++j) { const f32x2_t c2 = *(const f32x2_t*)(CW + j * 128 + cch * 8 + 2 * p); cl[j] = c2.x; chh[j] = c2.y; }
#pragma unroll
                for (int i = 0; i < 4; ++i) {
                    float sl = cl[0] * xl[i] + cl[1] * xl[i + 1] + cl[2] * xl[i + 2] + cl[3] * xl[i + 3];
                    float sh = chh[0] * xh[i] + chh[1] * xh[i + 1] + chh[2] * xh[i + 2] + chh[3] * xh[i + 3];
                    sl = sl * sigmoidf_(sl) * ksc; sh = sh * sigmoidf_(sh) * ksc;
                    opk[i][p] = cvtpk(sl, sh); wpk[i][p] = cvtpk(sl * wts[i], sh * wts[i]);
                }
            }
            bf16_t* dst = ((cch < 8) ? Q : K) + (4 * rblk) * 72 + (cch & 7) * 8;
#pragma unroll
            for (int i = 0; i < 4; ++i) { *(u32x4*)(dst + i * 72) = opk[i]; if (cch >= 8) *(u32x4*)(WK + (4 * rblk + i) * 72 + (cch - 8) * 8) = wpk[i]; }
#pragma unroll
            for (int i = 0; i < 2; ++i) { const int id = tid + 512 * i; *(u32x4*)(VV + (id >> 3) * 72 + (id & 7) * 8) = vr[i]; }
        }
        lds_barrier();
#pragma unroll
        for (int i = 0; i < 2; ++i) orw[i] = *(const u32x4*)(U + (rowbase + t0 + ft) * NU + U_MO + hd * 64 + fv0 + 8 * i);
        {
            const int vb = w & 1, tb = w >> 1, t = 32 * tb + r;
            bf16x8 qf[4];
#pragma unroll
            for (int ks = 0; ks < 4; ++ks) qf[ks] = ld8(Q + t * 72 + 16 * ks + 8 * h);
            f32x16 acc;
#pragma unroll
            for (int e = 0; e < 16; ++e) acc[e] = 0.f;
#pragma unroll
            for (int ks = 0; ks < 4; ++ks) { const bf16x8 a = ld8(CL + (32 * vb + r) * 72 + 16 * ks + 8 * h); acc = MFMA32(a, qf[ks], acc); }
            const float sc = scl[t], rt = rowt[t];
#pragma unroll
            for (int e = 0; e < 16; ++e) acc[e] *= sc;
            float dn = 0.f;
#pragma unroll
            for (int ks = 0; ks < 4; ++ks)
#pragma unroll
                for (int j = 0; j < 8; ++j) dn += bf2f((unsigned short)qf[ks][j]) * NV[16 * ks + 8 * h + j];
            dn += __shfl_xor(dn, 32);
            float dsum = 0.f;
#pragma unroll
            for (int sb = 0; sb < 4; ++sb) {
                if (sb <= tb) {
                    f32x16 st;
#pragma unroll
                    for (int e = 0; e < 16; ++e) st[e] = 0.f;
#pragma unroll
                    for (int ks = 0; ks < 4; ++ks) { const bf16x8 a = ld8(K + (32 * sb + r) * 72 + 16 * ks + 8 * h); st = MFMA32(a, qf[ks], st); }
#pragma unroll
                    for (int e = 0; e < 16; ++e) { const int sl = crow(e, h); float v = st[e] * __builtin_amdgcn_exp2f(rt + colt[32 * sb + sl]); if (sb == tb && sl > r) v = 0.f; st[e] = v; dsum += v; }
#pragma unroll
                    for (int s2 = 0; s2 < 2; ++s2) { const bf16x8 pf = pack8(st, s2); const bf16x8 a = tr_frag<true>(lds3 + ML_V, 144, 32 * sb + 16 * s2, 32 * vb, lane); acc = MFMA32(a, pf, acc); }
                }
            }
            dsum += __shfl_xor(dsum, 32);
            const float den = dsum + sc * dn;
            const float inv = __builtin_amdgcn_rcpf(fmaxf(fabsf(den), dfl[t]));
#pragma unroll
            for (int e = 0; e < 16; ++e) H[t * 65 + 32 * vb + crow(e, h)] = acc[e] * inv;
        }
        lds_barrier();
        if (c + 1 < T / 128) ML_PREFETCH(c + 1);
        {
            float hv[16]; float ss = 0.f;
#pragma unroll
            for (int e = 0; e < 16; ++e) { hv[e] = H[ft * 65 + fv0 + e]; ss += hv[e] * hv[e]; }
            ss += __shfl_xor(ss, 1); ss += __shfl_xor(ss, 2);
            const float rn = __builtin_amdgcn_rsqf(ss * (1.f / 64) + EPS);
            bf16_t* mp = MIX + (rowbase + t0 + ft) * D + hd * 64 + fv0;
#pragma unroll
            for (int g = 0; g < 2; ++g) { float og[8]; unpack8(orw[g], og); float ov2[8];
#pragma unroll
                for (int e = 0; e < 8; ++e) ov2[e] = hv[8 * g + e] * rn * NG[fv0 + 8 * g + e] * sigmoidf_(og[e]);
                *(u32x4*)(mp + 8 * g) = pack8f(ov2); }
        }
        if (w < 4) {
            const int vb2 = w & 1, kb2 = w >> 1;
            f32x16 cacc;
#pragma unroll
            for (int e = 0; e < 16; ++e) cacc[e] = CF[(32 * vb2 + crow(e, h)) * 65 + 32 * kb2 + r] * dec;
#pragma unroll
            for (int s2 = 0; s2 < 8; ++s2) { const bf16x8 a = tr_frag<false>(lds3 + ML_V, 144, 16 * s2, 32 * vb2, lane); const bf16x8 bb = tr_frag<false>(lds3 + ML_WK, 144, 16 * s2, 32 * kb2, lane); cacc = MFMA32(a, bb, cacc); }
#pragma unroll
            for (int e = 0; e < 16; ++e) { CF[(32 * vb2 + crow(e, h)) * 65 + 32 * kb2 + r] = cacc[e]; CL[(32 * vb2 + crow(e, h)) * 72 + 32 * kb2 + r] = (bf16_t)f2bf(cacc[e]); }
        } else if (w < 6) {
            const int kb2 = w - 4; const bf16x8 ones = {0x3f80, 0x3f80, 0x3f80, 0x3f80, 0x3f80, 0x3f80, 0x3f80, 0x3f80};
            f32x16 nacc;
#pragma unroll
            for (int e = 0; e < 16; ++e) nacc[e] = 0.f;
#pragma unroll
            for (int s2 = 0; s2 < 8; ++s2) { const bf16x8 bb = tr_frag<false>(lds3 + ML_WK, 144, 16 * s2, 32 * kb2, lane); nacc = MFMA32(ones, bb, nacc); }
            if (h == 0) NV[32 * kb2 + r] = dec * NV[32 * kb2 + r] + nacc[0];
        }
        lds_barrier();
    }
#undef ML_PREFETCH
}
constexpr int HG_TOT = 0, HG_Q0 = 2048, HG_QD = 11264, HG_KD = 20480, HG_KE = 29696, HG_V = 38912, HG_ST = 48128, HG_OH = 66560;
DI void hgrn_unit(const bf16_t* U, bf16_t* MIX, const float* LBl, const float* hn, int b, int hd, unsigned char* lds, int tid_in) {
    int tid = tid_in; asm volatile("" : "+v"(tid));
    const int lane = tid & 63, r = lane & 31, h = lane >> 5, w = __builtin_amdgcn_readfirstlane(tid >> 6);
    float* TOT = (float*)(lds + HG_TOT); bf16_t* Q0 = (bf16_t*)(lds + HG_Q0); bf16_t* QD = (bf16_t*)(lds + HG_QD); bf16_t* KD = (bf16_t*)(lds + HG_KD);
    bf16_t* KE = (bf16_t*)(lds + HG_KE); bf16_t* VV = (bf16_t*)(lds + HG_V); bf16_t* ST = (bf16_t*)(lds + HG_ST); float* OH = (float*)(lds + HG_OH);
    const lds_cp lds3 = (lds_cp)lds;
    const size_t rowbase = (size_t)b * T;
    __syncthreads();
    for (int i = tid; i < 64 * 72; i += NTHREADS) ST[i] = 0;
    f32x16 sacc;
#pragma unroll
    for (int e = 0; e < 16; ++e) sacc[e] = 0.f;
    const int tA = tid >> 3, k0 = (tid & 7) * 8;
    float lbv[8], hnv[8];
#pragma unroll
    for (int e = 0; e < 8; ++e) { lbv[e] = LBl[hd * 64 + k0 + e]; hnv[e] = hn[k0 + e]; }
    u32x4 nq, nf, nv, ng;
#define HG_PREFETCH(c_) do { const bf16_t* rp_ = U + (rowbase + 64 * (c_) + tA) * NU + hd * 64 + k0; nq = *(const u32x4*)(rp_ + U_HQ); nf = *(const u32x4*)(rp_ + U_HF); nv = *(const u32x4*)(rp_ + U_HI); ng = *(const u32x4*)(rp_ + U_HG); } while (0)
    HG_PREFETCH(0);
    int cur = 0;
    for (int c = 0; c < T / 64; ++c) {
        const size_t row = rowbase + 64 * c + tA;
        const u32x4 qw = nq, fw = nf, vw = nv, gw = ng;
        if (c + 1 < T / 64) HG_PREFETCH(c + 1);
        float qv[8], kk[8], bc[8];
        { float qp[8], fp[8]; unpack8(qw, qp); unpack8(fw, fp);
#pragma unroll
          for (int e = 0; e < 8; ++e) { qv[e] = qp[e] * sigmoidf_(qp[e]); const float ex = __expf(-fp[e]); const float sg = __builtin_amdgcn_rcpf(1.f + ex), sn = ex * sg;
              bc[e] = __logf(lbv[e] + (1.f - lbv[e]) * sg); kk[e] = (1.f - lbv[e]) * sn; } }
#pragma unroll
        for (int o = 8; o < 64; o <<= 1) {
#pragma unroll
            for (int e = 0; e < 8; ++e) { const float t_ = __shfl_up(bc[e], o); if (lane >= o) bc[e] += t_; } }
        if ((lane >> 3) == 7) { *(f32x4*)(TOT + w * 64 + k0) = (f32x4){bc[0], bc[1], bc[2], bc[3]}; *(f32x4*)(TOT + w * 64 + k0 + 4) = (f32x4){bc[4], bc[5], bc[6], bc[7]}; }
        *(u32x4*)(VV + tA * 72 + k0) = vw;
        lds_barrier();
        float r1[8], bl[8];
        {
#pragma unroll
            for (int e = 0; e < 8; ++e) { r1[e] = 0.f; bl[e] = 0.f; }
            float pre[8];
#pragma unroll
            for (int e = 0; e < 8; ++e) pre[e] = 0.f;
#pragma unroll
            for (int w2 = 0; w2 < 8; ++w2) { const f32x4 a = *(const f32x4*)(TOT + w2 * 64 + k0), c4 = *(const f32x4*)(TOT + w2 * 64 + k0 + 4);
                const float tv[8] = {a.x, a.y, a.z, a.w, c4.x, c4.y, c4.z, c4.w};
#pragma unroll
                for (int e = 0; e < 8; ++e) { if (w2 < w) pre[e] += tv[e]; if (w2 < 4) r1[e] += tv[e]; bl[e] += tv[e]; } }
#pragma unroll
            for (int e = 0; e < 8; ++e) bc[e] += pre[e];
        }
        {
            float q0[8], qd[8], kd[8], ke[8];
#pragma unroll
            for (int e = 0; e < 8; ++e) { const float rr = (w >= 4) ? r1[e] : 0.f;
                q0[e] = qv[e] * __expf(bc[e]); qd[e] = qv[e] * __expf(bc[e] - rr); kd[e] = kk[e] * __expf(rr - bc[e]); ke[e] = kk[e] * __expf(bl[e] - bc[e]); }
            *(u32x4*)(Q0 + tA * 72 + k0) = pack8f(q0); *(u32x4*)(QD + tA * 72 + k0) = pack8f(qd); *(u32x4*)(KD + tA * 72 + k0) = pack8f(kd); *(u32x4*)(KE + tA * 72 + k0) = pack8f(ke);
        }
        lds_barrier();
        if (w < 4) {
            const int vb = w & 1, tb = w >> 1, t = 32 * tb + r;
            bf16x8 qf0[4], qfd[4];
#pragma unroll
            for (int ks = 0; ks < 4; ++ks) { qf0[ks] = ld8(Q0 + t * 72 + 16 * ks + 8 * h); qfd[ks] = ld8(QD + t * 72 + 16 * ks + 8 * h); }
            f32x16 acc;
#pragma unroll
            for (int e = 0; e < 16; ++e) acc[e] = 0.f;
            const bf16_t* STc = ST + cur * 64 * 72;
#pragma unroll
            for (int ks = 0; ks < 4; ++ks) { const bf16x8 a = ld8(STc + (32 * vb + r) * 72 + 16 * ks + 8 * h); acc = MFMA32(a, qf0[ks], acc); }
#pragma unroll
            for (int sb = 0; sb < 2; ++sb) {
                if (sb <= tb) {
                    f32x16 st;
#pragma unroll
                    for (int e = 0; e < 16; ++e) st[e] = 0.f;
#pragma unroll
                    for (int ks = 0; ks < 4; ++ks) { const bf16x8 a = ld8(KD + (32 * sb + r) * 72 + 16 * ks + 8 * h); st = MFMA32(a, (sb == tb) ? qfd[ks] : qf0[ks], st); }
                    if (sb == tb) {
#pragma unroll
                        for (int e = 0; e < 16; ++e) if (crow(e, h) > r) st[e] = 0.f; }
#pragma unroll
                    for (int s2 = 0; s2 < 2; ++s2) { const bf16x8 pf = pack8(st, s2); const bf16x8 a = tr_frag<true>(lds3 + HG_V, 144, 32 * sb + 16 * s2, 32 * vb, lane); acc = MFMA32(a, pf, acc); }
                }
            }
#pragma unroll
            for (int e = 0; e < 16; ++e) OH[t * 65 + 32 * vb + crow(e, h)] = acc[e];
        } else {
            const int vb = w & 1, kb = (w >> 1) & 1;
            float dsum = 0.f;
#pragma unroll
            for (int w2 = 0; w2 < 8; ++w2) dsum += TOT[w2 * 64 + 32 * kb + r];
            const float dec = __expf(dsum);
#pragma unroll
            for (int e = 0; e < 16; ++e) sacc[e] *= dec;
#pragma unroll
            for (int s2 = 0; s2 < 4; ++s2) { const bf16x8 a = tr_frag<false>(lds3 + HG_V, 144, 16 * s2, 32 * vb, lane); const bf16x8 bb = tr_frag<false>(lds3 + HG_KE, 144, 16 * s2, 32 * kb, lane); sacc = MFMA32(a, bb, sacc); }
            bf16_t* STn = ST + (cur ^ 1) * 64 * 72;
#pragma unroll
            for (int e = 0; e < 16; ++e) STn[(32 * vb + crow(e, h)) * 72 + 32 * kb + r] = (bf16_t)f2bf(sacc[e]);
        }
        lds_barrier();
        {
            float ov[8]; float ss = 0.f;
#pragma unroll
            for (int e = 0; e < 8; ++e) { ov[e] = OH[tA * 65 + k0 + e]; ss += ov[e] * ov[e]; }
            ss += __shfl_xor(ss, 1); ss += __shfl_xor(ss, 2); ss += __shfl_xor(ss, 4);
            const float rn = __builtin_amdgcn_rsqf(ss * (1.f / 64) + EPS);
            float gp[8]; unpack8(gw, gp);
#pragma unroll
            for (int e = 0; e < 8; ++e) ov[e] = ov[e] * rn * hnv[e] * (gp[e] * sigmoidf_(gp[e]));
            *(u32x4*)(MIX + row * D + 768 + hd * 64 + k0) = pack8f(ov);
        }
        cur ^= 1;
    }
#undef HG_PREFETCH
    __syncthreads();
}
#define LAS __attribute__((address_space(3)))
#define XB_TMO      128
#define XB_XCNT(j)  (256  + 64 * (j))
#define XB_XSUB(j)  (1280 + 64 * (j))
#define XB_XGEN(j)  (2304 + 64 * (j))
#define XB_TOP      3328
#define XB_TOPGEN   3392
#define XCD_BAR_WORDS 3456
#define XB_SPIN_CAP (1u << 18)

__device__ __forceinline__ unsigned xb_ld(unsigned* p)              { return __hip_atomic_load(p, __ATOMIC_RELAXED, __HIP_MEMORY_SCOPE_AGENT); }
__device__ __forceinline__ unsigned xb_add(unsigned* p, unsigned v) { return __hip_atomic_fetch_add(p, v, __ATOMIC_RELAXED, __HIP_MEMORY_SCOPE_AGENT); }
__device__ __forceinline__ unsigned xb_xcc_id() { return (unsigned)__builtin_amdgcn_s_getreg((3 << 11) | 20) & 0xFu; }
#define XB_SPIN(cond, bar) do { unsigned _sp = 0; while (cond) { __builtin_amdgcn_s_sleep(1); \
    if ((++_sp & 255u) == 0u) { if (xb_ld(&(bar)[XB_TMO])) break; if (_sp > XB_SPIN_CAP) { atomicAdd(&(bar)[XB_TMO], 1u); break; } } } } while (0)

struct XcdBarrier {
    unsigned* bar; unsigned x;
    volatile LAS unsigned* st;
};

__device__ __forceinline__ XcdBarrier xcd_barrier_post(unsigned* bar, volatile LAS unsigned* st) {
    XcdBarrier b; b.bar = bar; b.x = xb_xcc_id(); b.st = st;
    if (threadIdx.x == 0) (void)xb_add(&bar[XB_XCNT(b.x)], 1u);
    return b;
}
__device__ __forceinline__ void xcd_barrier_complete(unsigned* bar, unsigned x, unsigned& nloc, unsigned& nx) {
    const unsigned G = gridDim.x * gridDim.y * gridDim.z;
    unsigned sum, cnt, mine, sp = 0u;
    for (;;) {
        sum = 0u; cnt = 0u; mine = 0u;
#pragma unroll
        for (unsigned j = 0; j < 16; ++j) { const unsigned c = xb_ld(&bar[XB_XCNT(j)]); sum += c; cnt += (c > 0u) ? 1u : 0u; mine = (j == x) ? c : mine; }
        if (sum == G) break;
        __builtin_amdgcn_s_sleep(1);
        if ((++sp & 255u) == 0u) { if (xb_ld(&bar[XB_TMO])) break; if (sp > XB_SPIN_CAP) { atomicAdd(&bar[XB_TMO], 1u); break; } }
    }
    nloc = mine > 0u ? mine : 1u; nx = cnt > 0u ? cnt : 1u;
}

__device__ __forceinline__ void xcd_barrier(const XcdBarrier& b, int tid_in) {
    asm volatile("s_waitcnt vmcnt(0)" ::: "memory");
    __syncthreads();
    if (tid_in == 0) {
        unsigned* bar = b.bar;
        __builtin_amdgcn_s_waitcnt(0);
        unsigned nloc = b.st[0], nx = b.st[1];
        if (nloc == 0u) { xcd_barrier_complete(bar, b.x, nloc, nx); b.st[0] = nloc; b.st[1] = nx; }
        const unsigned old = xb_add(&bar[XB_XSUB(b.x)], 1u);
        const unsigned gen = old / nloc;
        if (old + 1u == (gen + 1u) * nloc) {
            __builtin_amdgcn_fence(__ATOMIC_RELEASE, "agent");
            asm volatile("s_waitcnt vmcnt(0)" ::: "memory");
            const unsigned og = xb_add(&bar[XB_TOP], 1u);
            const unsigned tg = og / nx;
            if (og + 1u == (tg + 1u) * nx) xb_add(&bar[XB_TOPGEN], 1u);
            else XB_SPIN(xb_ld(&bar[XB_TOPGEN]) == tg, bar);
            __builtin_amdgcn_fence(__ATOMIC_ACQUIRE, "agent");
            xb_add(&bar[XB_XGEN(b.x)], 1u);
            asm volatile("s_waitcnt vmcnt(0)" ::: "memory");
        } else {
            XB_SPIN(xb_ld(&bar[XB_XGEN(b.x)]) == gen, bar);
            __builtin_amdgcn_fence(__ATOMIC_ACQUIRE, "agent");
            asm volatile("s_waitcnt vmcnt(0)" ::: "memory");
        }
    }
    __syncthreads();
}

#ifdef NO_G1
#define GC1 if (0)
#else
#define GC1
#endif
#ifdef NO_G2
#define GC2 if (0)
#else
#define GC2
#endif
#ifdef NO_G3
#define GC3 if (0)
#else
#define GC3
#endif
#ifdef NO_G4
#define GC4 if (0)
#else
#define GC4
#endif
#ifndef REP_MIX
#define REP_MIX 1
#endif
#ifndef REP_G1
#define REP_G1 1
#endif
#ifndef REP_UP
#define REP_UP 1
#endif
#ifndef MK_ONE_LAUNCH
#define MK_ONE_LAUNCH 1
#endif
constexpr int N_PHASES = 1 + 6 * DEPTH;
__global__ void __launch_bounds__(NTHREADS, 2) hymba_fwd(Params P) {
    extern __shared__ __attribute__((aligned(16))) unsigned char lds[];
    cg::grid_group grid = cg::this_grid();
    const int wv_k = __builtin_amdgcn_readfirstlane(threadIdx.x >> 6);
#define MYTID ({ int w__ = wv_k; asm volatile("" : "+s"(w__)); int l__ = (int)__builtin_amdgcn_mbcnt_hi(~0u, __builtin_amdgcn_mbcnt_lo(~0u, 0u)); asm volatile("" : "+v"(l__)); w__ * 64 + l__; })
#define LTID int tid = MYTID; asm volatile("" : "+v"(tid));
#define PTRS unsigned char* ws = P.ws; asm volatile("" : "+s"(ws)); unsigned* CTL = (unsigned*)(ws + WS_CTL); (void)CTL; \
    const float* PR = (const float*)(ws + WS_PAR); (void)PR; float* RP = (float*)(ws + WS_ROPE); (void)RP; float* SS = (float*)(ws + WS_SS); (void)SS; float* GATE = (float*)(ws + WS_GATE); (void)GATE; \
    bf16_t* XB = (bf16_t*)(ws + WS_XB); (void)XB; bf16_t* U = (bf16_t*)(ws + WS_U); (void)U; bf16_t* MIX = (bf16_t*)(ws + WS_MIX); (void)MIX; bf16_t* HB = (bf16_t*)(ws + WS_H); (void)HB; \
    unsigned char* wb = ws + WS_W + (size_t)l * W_LAYER; (void)wb;
    const int lo = P.ph_lo, hi = P.ph_hi;
#define IN(k) (lo <= (k) && (k) < hi)
    volatile LAS unsigned* bst = (volatile LAS unsigned*)((LAS unsigned char*)lds + LDS_BYTES - 32);
    if (threadIdx.x < 2) bst[threadIdx.x] = 0u;
    __syncthreads();
    XcdBarrier xbar = xcd_barrier_post((unsigned*)(P.ws + WS_CTL) + 1024, bst);
#define SEAM(k) do { if (IN(k) && IN((k) + 1)) { XcdBarrier xb2_ = xbar; asm volatile("" : "+s"(xb2_.bar)); xcd_barrier(xb2_, MYTID); } } while (0)
    if (P.ph_hi < 0) grid.sync();
#ifndef REP_P0
#define REP_P0 1
#endif
    if (IN(0)) { const int l = 0; PTRS for (int rep = 0; rep < REP_P0; ++rep) { p0_prep(P, lds, MYTID); { LTID row_prep(P.x, XB, SS, P.w_in, P.norm1_g, P.gate_b, GATE, (float*)lds, tid); } } }
    SEAM(0);
#ifdef PROBE_SYNC
    for (int i_ = 0; i_ < 10; ++i_) grid.sync();
#endif
#pragma unroll
    for (int l = 0; l < DEPTH; ++l) {
        const int pb = 1 + 6 * l;
        if (IN(pb + 0)) { PTRS
            if (l > 0) { LTID gates_prep(XB, SS + (2 * l) * M, (const float*)(ws + WS_WG) + l * 8 * D, PR + PAR_GB + l * 8, GATE, (float*)lds, tid); }
            pg8::Gemm g{XB, (const bf16_t*)(wb + W_IN), M, NU, D}; pg8::StaticOrder S; S.init(M, NU, gridDim.x, (int)blockIdx.x);
            pg8::EpiIn E{U, NU, SS + (2 * l) * M, RP, PR + PAR_QN + l * 64, PR + PAR_KN + l * 64};
            for (int rep = 0; rep < ((l == 0) ? REP_G1 : 1); ++rep)
            GC1 pg8::gemm_phase<pg8::EpiIn, pg8::StaticOrder, true, true>((PG8_LAS unsigned char*)lds, g, S, E, MYTID);
        }
        SEAM(pb + 0);
        if (IN(pb + 2)) { PTRS LTID
            volatile int* slot = (volatile int*)(lds + LDS_BYTES - 64);
            for (int rep = 0; rep < ((l == 0) ? REP_MIX : 1); ++rep)
            for (;;) {
                __syncthreads();
                if (tid == 0) *slot = (int)atomicAdd(CTL + 16 * l + rep, 1u);
                __syncthreads();
                const int id = *slot;
                if (id >= 128 + 1024) break;
                if (id < 64) {
#ifndef NO_ML
 mlstm_unit(U, GATE, MIX, PR + PAR_CW + l * 2048, PR + PAR_MN + l * 64, id >> 2, id & 3, lds, tid);
#endif
 }
                else if (id < 128) {
#ifndef NO_HG
 hgrn_unit(U, MIX, (const float*)(ws + WS_LB) + l * 256, PR + PAR_HN + l * 64, (id - 64) >> 2, (id - 64) & 3, lds, tid);
#endif
 }
                else {
#ifndef NO_AT
 const int a = id - 128; const int qb = 15 - (a >> 6), bh = a & 63;
                    int lsel = l; asm volatile("" : "+s"(lsel));
                    const float lam_init = (lsel == 0) ? 0.2f : 0.35550906759096926f;
                    const float lam = PR[PAR_LAMV + lsel];
                    attn_unit(U, MIX, bh >> 2, bh & 3, qb, lam, 1.f - lam_init, PR + PAR_SUB + l * 128, lds, tid);
#endif
 }
            }
        }
        SEAM(pb + 2);
        if (IN(pb + 3)) { PTRS
            pg8::Gemm g{MIX, (const bf16_t*)(wb + W_OUT), M, D, D}; pg8::StaticOrder S; S.init(M, D, gridDim.x, (int)blockIdx.x);
            pg8::EpiResidBf E{XB, P.out, D, SS + (2 * l + 1) * M, 0};
            GC2 pg8::gemm_phase<pg8::EpiResidBf, pg8::StaticOrder, true, true>((PG8_LAS unsigned char*)lds, g, S, E, MYTID);
        }
        SEAM(pb + 3);
        if (IN(pb + 4)) { PTRS
            pg8::Gemm g{XB, (const bf16_t*)(wb + W_UP), M, FF, D}; pg8::StaticOrder S; S.init(M, FF, gridDim.x, (int)blockIdx.x);
            pg8::EpiScaleBf16<1> E{HB, FF, SS + (2 * l + 1) * M};
            for (int rep = 0; rep < ((l == 0) ? REP_UP : 1); ++rep)
            GC3 pg8::gemm_phase<pg8::EpiScaleBf16<1>, pg8::StaticOrder, true, true>((PG8_LAS unsigned char*)lds, g, S, E, MYTID);
        }
        SEAM(pb + 4);
        if (IN(pb + 5)) { PTRS
            pg8::Gemm g{HB, (const bf16_t*)(wb + W_DN), M, D, FF}; pg8::StaticOrder S; S.init(M, D, gridDim.x, (int)blockIdx.x);
#ifdef PROBE_DN
            if (l == 0) { pg8::EpiScaleBf16<0> E2{XB, D, SS}; pg8::gemm_phase<pg8::EpiScaleBf16<0>, pg8::StaticOrder, true, true>((PG8_LAS unsigned char*)lds, g, S, E2, MYTID); }
#endif
            pg8::EpiResidBf E{XB, P.out, D, SS + ((2 * l + 2) & 3) * M, (l + 1 < DEPTH) ? 0 : 1};
            GC4 pg8::gemm_phase<pg8::EpiResidBf, pg8::StaticOrder, true, true>((PG8_LAS unsigned char*)lds, g, S, E, MYTID);
        }
        SEAM(pb + 5);
    }
#undef IN
#undef SEAM
}

extern "C" void kernel_launch(void* const* d_in, const int* in_sizes, int n_in, void* d_out, int out_size, void* d_ws, size_t ws_size, hipStream_t stream) {
    static int grid = 0;
    if (grid == 0) {
        if (n_in != 16 || in_sizes[0] != M * D || out_size != M * D || ws_size < WS_END) { fprintf(stderr, "kernel_launch: unexpected shapes (n_in %d in0 %d out %d ws %zu)\n", n_in, n_in > 0 ? in_sizes[0] : -1, out_size, ws_size); grid = -1; return; }
        int dev = 0, cus = 0, per_cu = 0;
        hipGetDevice(&dev); hipDeviceGetAttribute(&cus, hipDeviceAttributeMultiprocessorCount, dev);
        if (hipFuncSetAttribute((const void*)hymba_fwd, hipFuncAttributeMaxDynamicSharedMemorySize, LDS_BYTES) != hipSuccess) { fprintf(stderr, "kernel_launch: hipFuncSetAttribute failed\n"); grid = -1; return; }
        if (hipOccupancyMaxActiveBlocksPerMultiprocessor(&per_cu, (const void*)hymba_fwd, NTHREADS, LDS_BYTES) != hipSuccess || per_cu < 1) { fprintf(stderr, "kernel_launch: occupancy query gave %d\n", per_cu); per_cu = 1; }
        (void)hipGetLastError();
        grid = cus * per_cu;
        fprintf(stderr, "kernel_launch: grid %d (%d CUs x %d)\n", grid, cus, per_cu);
    }
    if (grid < 0) return;
    hipMemsetAsync((char*)d_ws + WS_CTL, 0, CTL_BYTES, stream);
    Params p{};
    p.x = (const float*)d_in[0]; p.norm1_g = (const float*)d_in[1]; p.w_in = (const float*)d_in[2]; p.conv_w = (const float*)d_in[3]; p.gate_b = (const float*)d_in[4]; p.mnorm_g = (const float*)d_in[5];
    p.qn_g = (const float*)d_in[6]; p.kn_g = (const float*)d_in[7]; p.lam = (const float*)d_in[8]; p.subln_g = (const float*)d_in[9]; p.lb_param = (const float*)d_in[10]; p.hnorm_g = (const float*)d_in[11];
    p.w_out = (const float*)d_in[12]; p.norm2_g = (const float*)d_in[13]; p.w_up = (const float*)d_in[14]; p.w_down = (const float*)d_in[15];
    p.out = (float*)d_out; p.ws = (unsigned char*)d_ws;
#if MK_ONE_LAUNCH
    p.ph_lo = 0; p.ph_hi = N_PHASES;
    void* args[] = {&p};
    hipError_t e = hipLaunchCooperativeKernel((const void*)hymba_fwd, dim3(grid), dim3(NTHREADS), args, LDS_BYTES, stream);
    if (e != hipSuccess) fprintf(stderr, "cooperative launch failed: %s (grid %d)\n", hipGetErrorString(e), grid);
#else
    for (int ph = 0; ph < N_PHASES; ++ph) { p.ph_lo = ph; p.ph_hi = ph + 1; hipLaunchKernelGGL(hymba_fwd, dim3(grid), dim3(NTHREADS), LDS_BYTES, stream, p); }
#endif
}
```

```cpp
#include <hip/hip_runtime.h>
#include <hip/hip_cooperative_groups.h>
#include <cstdio>
#include <cstdint>
namespace cg = cooperative_groups;
namespace pg8 {
#define PG8_LAS __attribute__((address_space(3)))
typedef unsigned short bf16_t;
typedef short bf16x8 __attribute__((ext_vector_type(8)));
typedef float f32x4 __attribute__((ext_vector_type(4)));
typedef unsigned u32x4 __attribute__((ext_vector_type(4)));
constexpr int BM = 256, BK = 64, HALF = 128, HTB = HALF * BK * 2  , STAGE_BYTES = 8 * HTB, NXCD = 8, WGM = 8;

__host__ __device__ __forceinline__ int lds_byte(int r, int c) { const int st = (r >> 4) * 2 + (c >> 5), rr = r & 15, cc = c & 31, ob = rr * 64 + cc * 2; return st * 1024 + (ob ^ (((ob >> 9) & 1) << 5)); }
__host__ __device__ __forceinline__ void stage_rc(int b, int& R, int& C) { const int st = b / 1024, sb = b % 1024, swz = sb ^ (((sb >> 9) & 1) << 5); R = (st >> 1) * 16 + swz / 64; C = (st & 1) * 32 + (swz % 64) / 2; }
__host__ __device__ __forceinline__ int perm32(int rho) { const int n = rho >> 4, i = rho & 15; return 8 * (i >> 2) + 4 * n + (i & 3); }

struct Unit { int pm, pn; };
struct Gemm { const bf16_t* A; const bf16_t* Bt; int M, N, K; };

struct StaticOrder {
    int nM, nN, nwg, G, c;
    __host__ __device__ void init(int M, int N, int G_, int c_) { nM = M / BM; nN = N / BM; nwg = nM * nN; G = G_; c = c_; }
    __host__ __device__ bool next(int i, Unit& u) const {
        const long L = (long)i * G + c; if (L >= nwg) return false;
        int wgid = (int)L; { const int q = nwg / NXCD, r = nwg % NXCD, xcd = wgid % NXCD, off = wgid / NXCD; wgid = (xcd < r ? xcd * (q + 1) : r * (q + 1) + (xcd - r) * q) + off; }
        const int nig = WGM * nN, gid = wgid / nig, fm = gid * WGM, gsz = (nM - fm) < WGM ? (nM - fm) : WGM;
        u.pm = fm + ((wgid % nig) % gsz); u.pn = (wgid % nig) / gsz; return true;
    }
    __device__ __forceinline__ void a_ready(const Unit&) const {}
    __device__ __forceinline__ void done(const Unit&) const {}
};

__device__ __forceinline__ unsigned cvt_pk_bf16(float lo, float hi) { unsigned r; asm volatile("v_cvt_pk_bf16_f32 %0, %1, %2" : "=v"(r) : "v"(lo), "v"(hi)); return r; }
typedef float f32x2 __attribute__((ext_vector_type(2)));
template <int ACT> struct EpiScaleBf16 {
    static constexpr bool PERM = true, AFTER_DRAIN = false;
    bf16_t* O; int ldc; const float* ss;
    __device__ __forceinline__ void operator()(const f32x4 (&acc)[2][2][4][2], const Unit& u, int wr, int wc, int fr, int fq) const {
        const int row0 = u.pm * BM + wr * 64 + fr; const int col0 = u.pn * BM + wc * 32 + 8 * fq;
        float sv[8];
#pragma unroll
        for (int g = 0; g < 8; ++g) sv[g] = ss[row0 + (g >> 2) * HALF + (g & 3) * 16];
#pragma unroll
        for (int ai = 0; ai < 2; ++ai)
#pragma unroll
            for (int m = 0; m < 4; ++m) { const int row = row0 + ai * HALF + m * 16; const float s = __builtin_amdgcn_rsqf(sv[ai * 4 + m] * (1.0f / 1024.0f) + 1e-6f); bf16_t* rowp = O + (size_t)row * ldc + col0;
#pragma unroll
                for (int bj = 0; bj < 2; ++bj) { f32x4 v0 = acc[ai][bj][m][0] * s, v1 = acc[ai][bj][m][1] * s;
                    if (ACT == 1) {
#pragma unroll
                        for (int e = 0; e < 4; ++e) { float a = v0[e] > 0.f ? v0[e] : 0.f; v0[e] = a * a; float b = v1[e] > 0.f ? v1[e] : 0.f; v1[e] = b * b; } }
                    u32x4 w; w.x = cvt_pk_bf16(v0[0], v0[1]); w.y = cvt_pk_bf16(v0[2], v0[3]); w.z = cvt_pk_bf16(v1[0], v1[1]); w.w = cvt_pk_bf16(v1[2], v1[3]);
                    *(u32x4*)(rowp + bj * HALF) = w; }
                if (m & 1) asm volatile("" ::: "memory"); }
    }
};
struct EpiResidBf {
    static constexpr bool PERM = true, AFTER_DRAIN = false;
    bf16_t* xb; float* out; int ldc; float* ssn; int last;
    __device__ __forceinline__ void operator()(const f32x4 (&acc)[2][2][4][2], const Unit& u, int wr, int wc, int fr, int fq) const {
        const int row0 = u.pm * BM + wr * 64 + fr; const int col0 = u.pn * BM + wc * 32 + 8 * fq;
#pragma unroll
        for (int ai = 0; ai < 2; ++ai) {
            u32x4 bs[4][2];
#pragma unroll
            for (int m = 0; m < 4; ++m) { const size_t off = (size_t)(row0 + ai * HALF + m * 16) * ldc + col0;
#pragma unroll
                for (int bj = 0; bj < 2; ++bj) bs[m][bj] = *(const u32x4*)(xb + off + bj * HALF); }
#pragma unroll
            for (int m = 0; m < 4; ++m) { const int row = row0 + ai * HALF + m * 16; const size_t off = (size_t)row * ldc + col0; float sq = 0.f;
#pragma unroll
                for (int bj = 0; bj < 2; ++bj) { const size_t idx = off + bj * HALF; const u32x4 b = bs[m][bj];
                    const f32x4 b0 = {__builtin_bit_cast(float, b.x << 16), __builtin_bit_cast(float, b.x & 0xffff0000u), __builtin_bit_cast(float, b.y << 16), __builtin_bit_cast(float, b.y & 0xffff0000u)};
                    const f32x4 b1 = {__builtin_bit_cast(float, b.z << 16), __builtin_bit_cast(float, b.z & 0xffff0000u), __builtin_bit_cast(float, b.w << 16), __builtin_bit_cast(float, b.w & 0xffff0000u)};
                    const f32x4 v0 = b0 + acc[ai][bj][m][0], v1 = b1 + acc[ai][bj][m][1];
                    if (last) { *(f32x4*)(out + idx) = v0; *(f32x4*)(out + idx + 4) = v1; }
                    else {
                        sq += (v0[0] * v0[0] + v0[1] * v0[1]) + (v0[2] * v0[2] + v0[3] * v0[3]) + (v1[0] * v1[0] + v1[1] * v1[1]) + (v1[2] * v1[2] + v1[3] * v1[3]);
                        u32x4 w; w.x = cvt_pk_bf16(v0[0], v0[1]); w.y = cvt_pk_bf16(v0[2], v0[3]); w.z = cvt_pk_bf16(v1[0], v1[1]); w.w = cvt_pk_bf16(v1[2], v1[3]);
                        *(u32x4*)(xb + idx) = w; } }
                if (!last) { sq += __shfl_xor(sq, 16); sq += __shfl_xor(sq, 32); if (fq == 0) atomicAdd(ssn + row, sq); } }
            asm volatile("" ::: "memory"); }
    }
};
struct EpiIn {
    static constexpr bool PERM = true, AFTER_DRAIN = false;
    bf16_t* O; int ldc; const float* ss; const float* RP; const float* qg; const float* kg;
    __device__ __forceinline__ void operator()(f32x4 (&acc)[2][2][4][2], const Unit& u, int wr, int wc, int fr, int fq) const {
        const int row0 = u.pm * BM + wr * 64 + fr; const int col0 = u.pn * BM + wc * 64 + 8 * fq;
        const bool qk = (u.pn >= 4) && (u.pn < 8);
        float sv[8];
#pragma unroll
        for (int g = 0; g < 8; ++g) sv[g] = ss[row0 + (g >> 2) * HALF + (g & 3) * 16];
        if (qk) {
            const bool isq = u.pn < 6; const float* gn = (isq ? qg : kg) + 8 * fq;
            float gv[2][8];
#pragma unroll
            for (int bj = 0; bj < 2; ++bj)
#pragma unroll
                for (int j = 0; j < 8; ++j) gv[bj][j] = gn[32 * bj + j];
            const float qs = isq ? 0.125f * 1.4426950408889634f : 1.0f;
            f32x4 rpn[4] = {{1.f, 0.f, 1.f, 0.f}, {1.f, 0.f, 1.f, 0.f}, {1.f, 0.f, 1.f, 0.f}, {1.f, 0.f, 1.f, 0.f}};
            const bool roper = fq < 2;
            if (roper) { const float* rp = RP + (size_t)(row0 & 2047) * 16; rpn[0] = *(const f32x4*)rp; rpn[1] = *(const f32x4*)(rp + 4); rpn[2] = *(const f32x4*)(rp + 8); rpn[3] = *(const f32x4*)(rp + 12); }
#pragma unroll
            for (int g = 0; g < 8; ++g) { const int ai = g >> 2, m = g & 3; const int row = row0 + ai * HALF + m * 16; bf16_t* rowp = O + (size_t)row * ldc + col0;
                const f32x4 a = rpn[0], b = rpn[1], c = rpn[2], d = rpn[3];
                if (g < 7 && roper) { const int rown = row0 + ((g + 1) >> 2) * HALF + ((g + 1) & 3) * 16; const float* rp = RP + (size_t)(rown & 2047) * 16;
                    rpn[0] = *(const f32x4*)rp; rpn[1] = *(const f32x4*)(rp + 4); rpn[2] = *(const f32x4*)(rp + 8); rpn[3] = *(const f32x4*)(rp + 12); }
                f32x4 c0 = (f32x4){a.x, a.z, b.x, b.z}, s0 = (f32x4){a.y, a.w, b.y, b.w}, c1 = (f32x4){c.x, c.z, d.x, d.z}, s1 = (f32x4){c.y, c.w, d.y, d.w};
                if (fq == 0) { s0 = -s0; s1 = -s1; }
                const float s = __builtin_amdgcn_rsqf(sv[g] * (1.0f / 1024.0f) + 1e-6f);
                f32x4 v[2][2]; float p = 0.f;
#pragma unroll
                for (int bj = 0; bj < 2; ++bj) { v[bj][0] = acc[ai][bj][m][0] * s; v[bj][1] = acc[ai][bj][m][1] * s;
                    p += (v[bj][0][0] * v[bj][0][0] + v[bj][0][1] * v[bj][0][1]) + (v[bj][0][2] * v[bj][0][2] + v[bj][0][3] * v[bj][0][3]) + (v[bj][1][0] * v[bj][1][0] + v[bj][1][1] * v[bj][1][1]) + (v[bj][1][2] * v[bj][1][2] + v[bj][1][3] * v[bj][1][3]); }
                p += __shfl_xor(p, 16); p += __shfl_xor(p, 32);
                const float rg = __builtin_amdgcn_rsqf(p * (1.0f / 64.0f) + 1e-6f);
#pragma unroll
                for (int bj = 0; bj < 2; ++bj) {
                    f32x4 v0 = v[bj][0] * rg, v1 = v[bj][1] * rg;
                    v0 = v0 * (f32x4){gv[bj][0], gv[bj][1], gv[bj][2], gv[bj][3]}; v1 = v1 * (f32x4){gv[bj][4], gv[bj][5], gv[bj][6], gv[bj][7]};
                    if (bj == 0) {
                        f32x4 o0, o1;
#pragma unroll
                        for (int e = 0; e < 4; ++e) { o0[e] = __shfl_xor(v0[e], 16); o1[e] = __shfl_xor(v1[e], 16); }
                        v0 = v0 * c0 + o0 * s0; v1 = v1 * c1 + o1 * s1; }
                    v0 = v0 * qs; v1 = v1 * qs;
                    u32x4 w; w.x = cvt_pk_bf16(v0[0], v0[1]); w.y = cvt_pk_bf16(v0[2], v0[3]); w.z = cvt_pk_bf16(v1[0], v1[1]); w.w = cvt_pk_bf16(v1[2], v1[3]);
                    *(u32x4*)(rowp + bj * 32) = w; }
                asm volatile("" ::: "memory"); }
        } else {
#pragma unroll
            for (int ai = 0; ai < 2; ++ai)
#pragma unroll
                for (int m = 0; m < 4; ++m) { const int row = row0 + ai * HALF + m * 16; const float s = __builtin_amdgcn_rsqf(sv[ai * 4 + m] * (1.0f / 1024.0f) + 1e-6f); bf16_t* rowp = O + (size_t)row * ldc + col0;
#pragma unroll
                    for (int bj = 0; bj < 2; ++bj) { const f32x4 v0 = acc[ai][bj][m][0] * s, v1 = acc[ai][bj][m][1] * s;
                        u32x4 w; w.x = cvt_pk_bf16(v0[0], v0[1]); w.y = cvt_pk_bf16(v0[2], v0[3]); w.z = cvt_pk_bf16(v1[0], v1[1]); w.w = cvt_pk_bf16(v1[2], v1[3]);
                        *(u32x4*)(rowp + bj * 32) = w; }
                    if (m & 1) asm volatile("" ::: "memory"); }
        }
    }
};
template <class Epi, class Sched, bool ALIGN_EPI = false, bool SP2 = false>
__device__ __forceinline__ void gemm_phase(PG8_LAS unsigned char* lds, const Gemm g, const Sched& S, const Epi& E, int tid_in) {
    int tid_l = tid_in; asm volatile("" : "+v"(tid_l));
    const int tid = tid_l, wid = __builtin_amdgcn_readfirstlane(tid >> 6), lane = tid & 63, wr = wid >> 2, wc = wid & 3, fr = lane & 15, fq = lane >> 4;
    const int K = g.K, nt = K / BK;
    unsigned voffA[2], voffB[2];
#pragma unroll
    for (int i = 0; i < 2; ++i) { int R, C; stage_rc(tid * 16 + i * 8192, R, C); const int Rb = Epi::PERM ? ((R & ~31) + perm32(R & 31)) : R;
        voffA[i] = (unsigned)(R * K + C) * 2u; voffB[i] = (unsigned)(Rb * K + C) * 2u; }
    const size_t kstep = (size_t)(BK * 2);
    const size_t hstep = (size_t)HALF * K * 2;
    const size_t tstep = 2 * hstep;
    const unsigned ldsw = (unsigned)wid * 1024u;
    const int aoff = lds_byte(wr * 64 + fr, fq * 8), boff = lds_byte(wc * 32 + fr, fq * 8);
#define PG8_SA(b, h) (((b) * 2 + (h)) * HTB)
#define PG8_SB(b, h) ((4 + (b) * 2 + (h)) * HTB)
#define PG8_STAGE(bufoff, gbase, voff) do { _Pragma("unroll") for (int _i = 0; _i < 2; ++_i) \
        __builtin_amdgcn_global_load_lds((const unsigned*)((const char*)(gbase) + (voff)[_i]), (PG8_LAS unsigned*)(lds + (bufoff) + ldsw + _i * 8192), 16, 0, 0); } while (0)
#define PG8_LDA(dst, b, h) do { _Pragma("unroll") for (int m = 0; m < 4; ++m) _Pragma("unroll") for (int k = 0; k < 2; ++k) dst[m][k] = *(const PG8_LAS bf16x8*)(lds + PG8_SA(b, h) + aoff + m * 2048 + k * 1024); } while (0)
#define PG8_LDB(dst, b, h) do { _Pragma("unroll") for (int n = 0; n < 2; ++n) _Pragma("unroll") for (int k = 0; k < 2; ++k) dst[n][k] = *(const PG8_LAS bf16x8*)(lds + PG8_SB(b, h) + boff + n * 2048 + k * 1024); } while (0)
#define PG8_MMA(ai, bj, At, Bt) do { __builtin_amdgcn_s_setprio(1); _Pragma("unroll") for (int m = 0; m < 4; ++m) _Pragma("unroll") for (int n = 0; n < 2; ++n) _Pragma("unroll") for (int k = 0; k < 2; ++k) \
        acc[ai][bj][m][n] = __builtin_amdgcn_mfma_f32_16x16x32_bf16(Bt[n][k], At[m][k], acc[ai][bj][m][n], 0, 0, 0); __builtin_amdgcn_s_setprio(0); } while (0)
#define PG8_WAIT_V(n) asm volatile("s_waitcnt vmcnt(" #n ")" ::: "memory")
#define PG8_WAIT_L(n) asm volatile("s_waitcnt lgkmcnt(" #n ")" ::: "memory")
#define PG8_BAR __builtin_amdgcn_s_barrier()
#define PG8_SCHED __builtin_amdgcn_sched_barrier(0)
    Unit cur, nxt; int ui = 0;
    if (!S.next(0, cur)) return;
    f32x4 acc[2][2][4][2];
#pragma unroll
    for (int a = 0; a < 2; ++a)
#pragma unroll
        for (int b = 0; b < 2; ++b)
#pragma unroll
            for (int m = 0; m < 4; ++m)
#pragma unroll
                for (int n = 0; n < 2; ++n) acc[a][b][m][n] = (f32x4){0.f, 0.f, 0.f, 0.f};
    bf16x8 At[4][2], B0[2][2], B1[2][2];
    const char* cA = (const char*)g.A + (size_t)cur.pm * tstep; const char* cB = (const char*)g.Bt + (size_t)cur.pn * tstep;
    S.a_ready(cur);
    if constexpr (SP2) {
        PG8_STAGE(PG8_SB(0, 0), cB, voffB); PG8_STAGE(PG8_SB(0, 1), cB + hstep, voffB); PG8_STAGE(PG8_SA(0, 0), cA, voffA); PG8_STAGE(PG8_SA(0, 1), cA + hstep, voffA);
        if (wr == 1) PG8_BAR;
        PG8_WAIT_V(2); PG8_BAR;
        PG8_STAGE(PG8_SB(1, 0), cB + kstep, voffB); PG8_STAGE(PG8_SA(1, 0), cA + kstep, voffA); PG8_STAGE(PG8_SB(1, 1), cB + hstep + kstep, voffB);
        PG8_WAIT_V(6); PG8_BAR;
    } else {
        PG8_STAGE(PG8_SB(0, 0), cB, voffB); PG8_STAGE(PG8_SA(0, 0), cA, voffA); PG8_STAGE(PG8_SB(0, 1), cB + hstep, voffB); PG8_STAGE(PG8_SA(0, 1), cA + hstep, voffA);
        if (wr == 1) PG8_BAR;
        PG8_WAIT_V(4); PG8_BAR;
        PG8_STAGE(PG8_SB(1, 0), cB + kstep, voffB); PG8_STAGE(PG8_SA(1, 0), cA + kstep, voffA); PG8_STAGE(PG8_SB(1, 1), cB + hstep + kstep, voffB);
        PG8_WAIT_V(6); PG8_BAR;
    }
    for (;;) {
        const bool has_next = S.next(ui + 1, nxt);
        const char* nA = has_next ? (const char*)g.A + (size_t)nxt.pm * tstep : cA; const char* nB = has_next ? (const char*)g.Bt + (size_t)nxt.pn * tstep : cB;
        for (int t = 0; t < nt; t += 2) {
            const bool last = (t == nt - 2);
            const char* a1 = cA + (size_t)(t + 1) * kstep;
            const char* a2 = last ? nA : cA + (size_t)(t + 2) * kstep; const char* b2 = last ? nB : cB + (size_t)(t + 2) * kstep;
            const char* a3 = a2 + kstep; const char* b3 = b2 + kstep;
            if (last && has_next) S.a_ready(nxt);
            if constexpr (SP2) {
            PG8_LDB(B0, 0, 0); PG8_LDB(B1, 0, 1); PG8_SCHED; PG8_LDA(At, 0, 0); PG8_STAGE(PG8_SA(1, 1), a1 + hstep, voffA);
            PG8_WAIT_V(8); PG8_WAIT_L(0); PG8_BAR; PG8_MMA(0, 0, At, B0); PG8_MMA(0, 1, At, B1); PG8_BAR; PG8_SCHED;
            PG8_LDA(At, 0, 1); PG8_STAGE(PG8_SB(0, 0), b2, voffB); PG8_STAGE(PG8_SB(0, 1), b2 + hstep, voffB); PG8_STAGE(PG8_SA(0, 0), a2, voffA);
            PG8_WAIT_V(8); PG8_WAIT_L(0); PG8_BAR; PG8_MMA(1, 0, At, B0); PG8_MMA(1, 1, At, B1); PG8_BAR; PG8_SCHED;
            PG8_LDB(B0, 1, 0); PG8_LDB(B1, 1, 1); PG8_SCHED; PG8_LDA(At, 1, 0); PG8_STAGE(PG8_SA(0, 1), a2 + hstep, voffA);
            PG8_WAIT_V(8); PG8_WAIT_L(0); PG8_BAR; PG8_MMA(0, 0, At, B0); PG8_MMA(0, 1, At, B1); PG8_BAR; PG8_SCHED;
            PG8_LDA(At, 1, 1); PG8_STAGE(PG8_SB(1, 0), b3, voffB); PG8_STAGE(PG8_SB(1, 1), b3 + hstep, voffB); PG8_STAGE(PG8_SA(1, 0), a3, voffA);
            PG8_WAIT_V(8); PG8_WAIT_L(0); PG8_BAR; PG8_MMA(1, 0, At, B0); PG8_MMA(1, 1, At, B1); PG8_BAR; PG8_SCHED;
            } else {
            PG8_LDB(B0, 0, 0); PG8_SCHED; PG8_LDA(At, 0, 0); PG8_STAGE(PG8_SA(1, 1), a1 + hstep, voffA);
            PG8_WAIT_L(8); PG8_BAR; PG8_WAIT_L(0); PG8_MMA(0, 0, At, B0); PG8_BAR; PG8_SCHED;
            PG8_LDB(B1, 0, 1); PG8_STAGE(PG8_SB(0, 0), b2, voffB);
            PG8_BAR; PG8_WAIT_L(0); PG8_MMA(0, 1, At, B1); PG8_BAR;
            PG8_LDA(At, 0, 1); PG8_STAGE(PG8_SA(0, 0), a2, voffA);
            PG8_BAR; PG8_WAIT_L(0); PG8_MMA(1, 0, At, B0); PG8_BAR; PG8_SCHED;
            PG8_STAGE(PG8_SB(0, 1), b2 + hstep, voffB);
            PG8_WAIT_V(6); PG8_BAR; PG8_MMA(1, 1, At, B1); PG8_BAR;
            PG8_LDB(B0, 1, 0); PG8_SCHED; PG8_LDA(At, 1, 0); PG8_STAGE(PG8_SA(0, 1), a2 + hstep, voffA);
            PG8_WAIT_L(8); PG8_BAR; PG8_WAIT_L(0); PG8_MMA(0, 0, At, B0); PG8_BAR; PG8_SCHED;
            PG8_LDB(B1, 1, 1); PG8_STAGE(PG8_SB(1, 0), b3, voffB);
            PG8_BAR; PG8_WAIT_L(0); PG8_MMA(0, 1, At, B1); PG8_BAR;
            PG8_LDA(At, 1, 1); PG8_STAGE(PG8_SA(1, 0), a3, voffA);
            PG8_BAR; PG8_WAIT_L(0); PG8_MMA(1, 0, At, B0); PG8_BAR; PG8_SCHED;
            PG8_STAGE(PG8_SB(1, 1), b3 + hstep, voffB);
            PG8_WAIT_V(6); PG8_BAR; PG8_MMA(1, 1, At, B1); PG8_BAR;
            }
        }
        if constexpr (ALIGN_EPI) { if (wr == 0) PG8_BAR; }
        if constexpr (!Epi::AFTER_DRAIN) { E(acc, cur, wr, wc, fr, fq); S.done(cur); }
        if (!has_next) break;
#pragma unroll
        for (int a = 0; a < 2; ++a)
#pragma unroll
            for (int b = 0; b < 2; ++b)
#pragma unroll
                for (int m = 0; m < 4; ++m)
#pragma unroll
                    for (int n = 0; n < 2; ++n) acc[a][b][m][n] = (f32x4){0.f, 0.f, 0.f, 0.f};
        cur = nxt; cA = nA; cB = nB; ++ui;
        if constexpr (ALIGN_EPI) { if (wr == 1) PG8_BAR; }
    }
    PG8_WAIT_V(0);
    if constexpr (!ALIGN_EPI) { if (wr == 0) PG8_BAR; }
    PG8_BAR;
    if constexpr (Epi::AFTER_DRAIN) { E.fused(acc, cur, wr, wc, fr, fq, lds, wid, lane); S.done(cur); }
#undef PG8_SA
#undef PG8_SB
#undef PG8_STAGE
#undef PG8_LDA
#undef PG8_LDB
#undef PG8_MMA
#undef PG8_WAIT_V
#undef PG8_WAIT_L
#undef PG8_BAR
#undef PG8_SCHED
}
}
#define DI __device__ __forceinline__
typedef unsigned short bf16_t;
typedef short bf16x8 __attribute__((ext_vector_type(8)));
typedef short s16x4 __attribute__((ext_vector_type(4)));
typedef float f32x16 __attribute__((ext_vector_type(16)));
typedef float f32x4 __attribute__((ext_vector_type(4)));
typedef unsigned u32x4 __attribute__((ext_vector_type(4)));
typedef unsigned u32x2 __attribute__((ext_vector_type(2)));
constexpr int NB = 16, T = 2048, D = 1024, M = NB * T, FF = 4096, DEPTH = 2;
constexpr int NU = 3584;
constexpr int DIN = 3592;
constexpr float EPS = 1e-6f;
constexpr int U_MQ = 0, U_MK = 256, U_MV = 512, U_MO = 768, U_AQ = 1024, U_AK = 1536, U_AV = 2048, U_HQ = 2560, U_HF = 2816, U_HI = 3072, U_HG = 3328;
constexpr float LOG2E = 1.4426950408889634f;
constexpr size_t MiB = 1u << 20;
constexpr size_t WS_CTL = 0, CTL_BYTES = 65536;
constexpr size_t WS_ROPE = 1 * MiB;
constexpr size_t WS_SS = 2 * MiB;
constexpr size_t WS_GATE = 3 * MiB;
constexpr size_t WS_WG = 4 * MiB;
constexpr size_t WS_LB = 4 * MiB + 512 * 1024;
constexpr size_t WS_PAR = 4 * MiB + 768 * 1024;
constexpr int PAR_GB = 0, PAR_MN = 64, PAR_QN = 192, PAR_KN = 320, PAR_LAM = 448, PAR_SUB = 960, PAR_HN = 1216, PAR_CW = 1344, PAR_N = 5440, PAR_LAMV = 5440;
constexpr size_t WS_W = 5 * MiB;
constexpr size_t W_LAYER = 25 * MiB, W_IN = 0, W_OUT = 7 * MiB, W_UP = 9 * MiB, W_DN = 17 * MiB;
constexpr size_t WS_XB = 56 * MiB;
constexpr size_t WS_U = 120 * MiB;
constexpr size_t WS_MIX = 344 * MiB;
constexpr size_t WS_H = 120 * MiB;
constexpr size_t WS_END = 408 * MiB;
constexpr int LDS_BYTES = 147456;
constexpr int NTHREADS = 512;

DI unsigned f2bf(float f) { unsigned u = __builtin_bit_cast(unsigned, f); return (u + 0x7fffu + ((u >> 16) & 1u)) >> 16; }
DI float bf2f(unsigned short b) { return __builtin_bit_cast(float, (unsigned)b << 16); }
typedef float f32x2_t __attribute__((ext_vector_type(2))); typedef __bf16 bf16x2_t __attribute__((ext_vector_type(2)));
DI unsigned cvtpk(float lo, float hi) { f32x2_t v = {lo, hi}; bf16x2_t b = __builtin_convertvector(v, bf16x2_t); return __builtin_bit_cast(unsigned, b); }
DI bf16x8 pack8(const f32x16& x, int s) { u32x4 p; p.x = cvtpk(x[8 * s], x[8 * s + 1]); p.y = cvtpk(x[8 * s + 2], x[8 * s + 3]); p.z = cvtpk(x[8 * s + 4], x[8 * s + 5]); p.w = cvtpk(x[8 * s + 6], x[8 * s + 7]); return __builtin_bit_cast(bf16x8, p); }
DI int crow(int reg, int h) { return (reg & 3) + 8 * (reg >> 2) + 4 * h; }
#define MFMA32(a, b, c) __builtin_amdgcn_mfma_f32_32x32x16_bf16((a), (b), (c), 0, 0, 0)
DI bf16x8 ld8(const bf16_t* p) { return *(const bf16x8*)p; }
DI bf16x8 ld_perm(const bf16_t* p, int h) { const s16x4 lo = *(const s16x4*)(p + 4 * h), hi = *(const s16x4*)(p + 8 + 4 * h); return __builtin_shufflevector(lo, hi, 0, 1, 2, 3, 4, 5, 6, 7); }
DI void lds_barrier() { asm volatile("s_waitcnt lgkmcnt(0)" ::: "memory"); __builtin_amdgcn_s_barrier(); asm volatile("" ::: "memory"); }
DI float sigmoidf_(float x) { return __builtin_amdgcn_rcpf(1.f + __expf(-x)); }
DI float wave_sum(float v) {
#pragma unroll
    for (int o = 1; o < 64; o <<= 1) v += __shfl_xor(v, o);
    return v;
}
DI void unpack8(const u32x4& w, float* f) {
    f[0] = __builtin_bit_cast(float, w.x << 16); f[1] = __builtin_bit_cast(float, w.x & 0xffff0000u);
    f[2] = __builtin_bit_cast(float, w.y << 16); f[3] = __builtin_bit_cast(float, w.y & 0xffff0000u);
    f[4] = __builtin_bit_cast(float, w.z << 16); f[5] = __builtin_bit_cast(float, w.z & 0xffff0000u);
    f[6] = __builtin_bit_cast(float, w.w << 16); f[7] = __builtin_bit_cast(float, w.w & 0xffff0000u);
}
DI u32x4 pack8f(const float* f) { u32x4 w; w.x = cvtpk(f[0], f[1]); w.y = cvtpk(f[2], f[3]); w.z = cvtpk(f[4], f[5]); w.w = cvtpk(f[6], f[7]); return w; }

struct Params {
    const float* x; const float* norm1_g; const float* w_in; const float* conv_w; const float* gate_b; const float* mnorm_g;
    const float* qn_g; const float* kn_g; const float* lam; const float* subln_g; const float* lb_param; const float* hnorm_g;
    const float* w_out; const float* norm2_g; const float* w_up; const float* w_down;
    float* out; unsigned char* ws; int ph_lo, ph_hi;
};

struct TDesc { const float* W; bf16_t* WT; const float* g; int K, Nsrc, skip_from, skip, k0, n0, wide; };
DI TDesc tt_decode(const Params& P, int it) {
    constexpr int T_IN = (D / 64) * (NU / 256), T_OUT = (D / 64) * (D / 256), T_UP = (D / 64) * (FF / 256), T_DN = (FF / 64) * (D / 256), T_L = T_IN + T_OUT + T_UP + T_DN;
    const int l = it / T_L; int r = it % T_L; unsigned char* wb = P.ws + WS_W + (size_t)l * W_LAYER; TDesc d;
    if (r < T_IN) { d.W = P.w_in + (size_t)l * D * DIN; d.WT = (bf16_t*)(wb + W_IN); d.g = P.norm1_g + l * D; d.K = D; d.Nsrc = DIN; d.skip_from = 1024; d.skip = 8; d.k0 = (r / (NU / 256)) * 64; d.n0 = (r % (NU / 256)) * 256; d.wide = 1; return d; } r -= T_IN;
    if (r < T_OUT) { d.W = P.w_out + (size_t)l * D * D; d.WT = (bf16_t*)(wb + W_OUT); d.g = nullptr; d.K = D; d.Nsrc = D; d.skip_from = 1 << 30; d.skip = 0; d.k0 = (r / (D / 256)) * 64; d.n0 = (r % (D / 256)) * 256; d.wide = 0; return d; } r -= T_OUT;
    if (r < T_UP) { d.W = P.w_up + (size_t)l * D * FF; d.WT = (bf16_t*)(wb + W_UP); d.g = P.norm2_g + l * D; d.K = D; d.Nsrc = FF; d.skip_from = 1 << 30; d.skip = 0; d.k0 = (r / (FF / 256)) * 64; d.n0 = (r % (FF / 256)) * 256; d.wide = 0; return d; } r -= T_UP;
    d.W = P.w_down + (size_t)l * FF * D; d.WT = (bf16_t*)(wb + W_DN); d.g = nullptr; d.K = FF; d.Nsrc = D; d.skip_from = 1 << 30; d.skip = 0; d.k0 = (r / (D / 256)) * 64; d.n0 = (r % (D / 256)) * 256; d.wide = 0; return d;
}
DI void tt_load(const TDesc& d, float (&v)[32], int tid) {
    const int c = tid & 255, rr = tid >> 8;
    const int cl = d.wide ? (64 * ((c >> 5) & 3) + 32 * (c >> 7) + (c & 31)) : c;
    const int nsrc = d.n0 + cl + ((d.n0 + cl) >= d.skip_from ? d.skip : 0);
#pragma unroll
    for (int i = 0; i < 32; ++i) v[i] = d.W[(size_t)(d.k0 + rr + 2 * i) * d.Nsrc + nsrc];
}
DI void tt_finish(const TDesc& d, float (&v)[32], float* scr, int tid) {
    const int c = tid & 255, rr = tid >> 8;
    if (d.g) {
#pragma unroll
        for (int i = 0; i < 32; ++i) v[i] *= d.g[d.k0 + rr + 2 * i]; }
#pragma unroll
    for (int i = 0; i < 32; ++i) scr[c * 65 + rr + 2 * i] = v[i];
    __syncthreads();
#pragma unroll
    for (int i = 0; i < 4; ++i) { const int id = tid + 512 * i, n = id >> 3, kc = (id & 7) * 8;
        float f[8];
#pragma unroll
        for (int j = 0; j < 8; ++j) f[j] = scr[n * 65 + kc + j];
        *(u32x4*)(d.WT + (size_t)(d.n0 + n) * d.K + d.k0 + kc) = pack8f(f); }
    __syncthreads();
}
DI void p0_prep(const Params& P, unsigned char* lds, int tid_in) {
    float* scr = (float*)lds; int tid = tid_in; asm volatile("" : "+v"(tid));
    constexpr int T_IN = (D / 64) * (NU / 256), T_OUT = (D / 64) * (D / 256), T_UP = (D / 64) * (FF / 256), T_DN = (FF / 64) * (D / 256), T_L = T_IN + T_OUT + T_UP + T_DN;
    {
        int it = blockIdx.x;
        if (it < DEPTH * T_L) {
            TDesc d = tt_decode(P, it); float v[32]; tt_load(d, v, tid);
            for (;;) {
                const int itn = it + gridDim.x; const bool more = itn < DEPTH * T_L;
                TDesc dn = d; float vn[32];
                if (more) { dn = tt_decode(P, itn); tt_load(dn, vn, tid); }
                tt_finish(d, v, scr, tid);
                if (!more) break;
                d = dn; it = itn;
#pragma unroll
                for (int i = 0; i < 32; ++i) v[i] = vn[i];
            }
        }
    }
    const int gt = blockIdx.x * NTHREADS + tid, NT_ = gridDim.x * NTHREADS;
    float* WG = (float*)(P.ws + WS_WG);
    for (int i = gt; i < DEPTH * 8 * D; i += NT_) { const int l = i / (8 * D), j = (i / D) % 8, k = i % D; WG[i] = P.norm1_g[l * D + k] * P.w_in[(size_t)l * D * DIN + (size_t)k * DIN + 1024 + j]; }
    { float* PR = (float*)(P.ws + WS_PAR);
      for (int i = gt; i < PAR_N; i += NT_) { float v;
        if (i < PAR_MN) v = (i < 16) ? P.gate_b[i] : 0.f; else if (i < PAR_QN) v = P.mnorm_g[i - PAR_MN]; else if (i < PAR_KN) v = P.qn_g[i - PAR_QN]; else if (i < PAR_LAM) v = P.kn_g[i - PAR_KN];
        else if (i < PAR_SUB) v = P.lam[i - PAR_LAM]; else if (i < PAR_HN) v = P.subln_g[i - PAR_SUB]; else if (i < PAR_CW) v = P.hnorm_g[i - PAR_HN]; else v = P.conv_w[i - PAR_CW];
        PR[i] = v; } }
    { float* SS = (float*)(P.ws + WS_SS); for (int i = gt; i < 3 * M; i += NT_) SS[M + i] = 0.f; }
    if (blockIdx.x == 0 && tid < 64) {
        for (int l = 0; l < DEPTH; ++l) { const float* lv = P.lam + l * 256; const float s1 = wave_sum(lv[tid] * lv[64 + tid]), s2 = wave_sum(lv[128 + tid] * lv[192 + tid]);
            const float lam_init = (l == 0) ? 0.2f : 0.35550906759096926f;
            if (tid == 0) ((float*)(P.ws + WS_PAR))[PAR_LAMV + l] = __expf(s1) - __expf(s2) + lam_init; } }
    float* LB = (float*)(P.ws + WS_LB);
    for (int i = gt; i < 256; i += NT_) { const float a = P.lb_param[i], b = P.lb_param[256 + i]; const float mx = fmaxf(a, b); const float ea = __expf(a - mx), eb = __expf(b - mx); LB[i] = 0.f; LB[256 + i] = eb / (ea + eb); }
    float* RP = (float*)(P.ws + WS_ROPE);
    for (int i = gt; i < T * 8; i += NT_) {
        const int pos = i >> 3, fi = i & 7;
        const float inv = fi == 0 ? 1.0f : fi == 1 ? 0.1939227432012558f : fi == 2 ? 0.03760603070259094f : fi == 3 ? 0.007292664609849453f : fi == 4 ? 0.0014142135623842478f
                        : fi == 5 ? 0.00027424818836152554f : fi == 6 ? 5.318296098266728e-05f : 1.0313386155758053e-05f;
        const float af = (float)pos * inv; const double xx = (double)af;
        const double kq = __builtin_rint(xx * 0.63661977236758134308); const double r = (xx - kq * 1.57079632679489661923) ; const double r2 = r * r;
        const double sn = r * (1.0 + r2 * (-1.0 / 6 + r2 * (1.0 / 120 + r2 * (-1.0 / 5040 + r2 * (1.0 / 362880 + r2 * (-1.0 / 39916800 + r2 * (1.0 / 6227020800.0)))))));
        const double cs = 1.0 + r2 * (-0.5 + r2 * (1.0 / 24 + r2 * (-1.0 / 720 + r2 * (1.0 / 40320 + r2 * (-1.0 / 3628800 + r2 * (1.0 / 479001600.0))))));
        const int qd = ((int)kq) & 3;
        const double s_ = (qd == 0) ? sn : (qd == 1) ? cs : (qd == 2) ? -sn : -cs;
        const double c_ = (qd == 0) ? cs : (qd == 1) ? -sn : (qd == 2) ? -cs : sn;
        RP[2 * i] = (float)c_; RP[2 * i + 1] = (float)s_;
    }
}

DI void row_prep(const float* X, bf16_t* XB, float* SS, const float* w_in0, const float* g1, const float* gb, float* GATE, float* wlds, int tid) {
    for (int k = tid; k < D; k += NTHREADS) { const f32x4 a = *(const f32x4*)(w_in0 + (size_t)k * DIN + 1024), c = *(const f32x4*)(w_in0 + (size_t)k * DIN + 1028); const float g = g1[k];
        wlds[0 * D + k] = a.x * g; wlds[1 * D + k] = a.y * g; wlds[2 * D + k] = a.z * g; wlds[3 * D + k] = a.w * g; wlds[4 * D + k] = c.x * g; wlds[5 * D + k] = c.y * g; wlds[6 * D + k] = c.z * g; wlds[7 * D + k] = c.w * g; }
    __syncthreads();
    const int lane = tid & 63, wv = tid >> 6; const int gw = blockIdx.x * 8 + wv, NGW = gridDim.x * 8;
    for (int m = gw; m < M; m += 2 * NGW) {
        const int m2 = m + NGW;
        const f32x4* xr = (const f32x4*)(X + (size_t)m * D) + lane; const f32x4* xr2 = (const f32x4*)(X + (size_t)(m2 < M ? m2 : m) * D) + lane;
        f32x4 v[4], v2[4]; float s = 0.f, s2 = 0.f;
#pragma unroll
        for (int j = 0; j < 4; ++j) { v[j] = xr[64 * j]; v2[j] = xr2[64 * j]; }
#pragma unroll
        for (int j = 0; j < 4; ++j) { s += (v[j].x * v[j].x + v[j].y * v[j].y) + (v[j].z * v[j].z + v[j].w * v[j].w); s2 += (v2[j].x * v2[j].x + v2[j].y * v2[j].y) + (v2[j].z * v2[j].z + v2[j].w * v2[j].w); }
        s = wave_sum(s); s2 = wave_sum(s2);
        u32x2* o8 = (u32x2*)(XB + (size_t)m * D) + lane;
#pragma unroll
        for (int j = 0; j < 4; ++j) { u32x2 w; w.x = cvtpk(v[j].x, v[j].y); w.y = cvtpk(v[j].z, v[j].w); o8[64 * j] = w; }
        if (lane == 0) SS[m] = s;
        if (m2 < M) { u32x2* o82 = (u32x2*)(XB + (size_t)m2 * D) + lane;
#pragma unroll
            for (int j = 0; j < 4; ++j) { u32x2 w; w.x = cvtpk(v2[j].x, v2[j].y); w.y = cvtpk(v2[j].z, v2[j].w); o82[64 * j] = w; }
            if (lane == 0) SS[m2] = s2; }
        float g1v = 0.f, g2v = 0.f;
#pragma unroll
        for (int g = 0; g < 8; ++g) { float a = 0.f, a2 = 0.f;
#pragma unroll
            for (int j = 0; j < 4; ++j) { const f32x4 w = *(const f32x4*)(wlds + g * D + 256 * j + 4 * lane);
                a += (v[j].x * w.x + v[j].y * w.y) + (v[j].z * w.z + v[j].w * w.w); a2 += (v2[j].x * w.x + v2[j].y * w.y) + (v2[j].z * w.z + v2[j].w * w.w); }
            a = wave_sum(a); a2 = wave_sum(a2); g1v = (lane == g) ? a : g1v; g2v = (lane == g) ? a2 : g2v; }
        if (lane < 8) { GATE[(size_t)m * 8 + lane] = g1v * __builtin_amdgcn_rsqf(s * (1.0f / D) + EPS) + gb[lane];
            if (m2 < M) GATE[(size_t)m2 * 8 + lane] = g2v * __builtin_amdgcn_rsqf(s2 * (1.0f / D) + EPS) + gb[lane]; }
    }
    __syncthreads();
}
DI void gates_prep(const bf16_t* XB, const float* SS, const float* WG, const float* gb, float* GATE, float* wlds, int tid) {
    bf16_t* wb = (bf16_t*)wlds;
    for (int i = tid; i < 8 * D / 8; i += NTHREADS) { const f32x4 a = ((const f32x4*)WG)[2 * i], c = ((const f32x4*)WG)[2 * i + 1]; const float t8[8] = {a.x, a.y, a.z, a.w, c.x, c.y, c.z, c.w}; ((u32x4*)wb)[i] = pack8f(t8); }
    __syncthreads();
    const int lane = tid & 63, r = lane & 31, h = lane >> 5, wv = tid >> 6;
    for (int blk = blockIdx.x * 8 + wv; blk < M / 32; blk += gridDim.x * 8) {
        const int m0 = blk * 32;
        const bf16_t* xr = XB + (size_t)(m0 + r) * D + 8 * h;
        f32x16 acc;
#pragma unroll
        for (int e = 0; e < 16; ++e) acc[e] = 0.f;
#pragma unroll 8
        for (int ks = 0; ks < D / 16; ++ks) {
            const bf16x8 a = *(const bf16x8*)(xr + 16 * ks);
            bf16x8 bfr = {0, 0, 0, 0, 0, 0, 0, 0};
            if (r < 8) bfr = *(const bf16x8*)(wb + r * D + 16 * ks + 8 * h);
            acc = MFMA32(a, bfr, acc);
        }
        if (r < 8) { const float bias = gb[r];
#pragma unroll
            for (int e = 0; e < 16; ++e) { const int m = m0 + crow(e, h); GATE[(size_t)m * 8 + r] = acc[e] * __builtin_amdgcn_rsqf(SS[m] * (1.0f / D) + EPS) + bias; } }
    }
    __syncthreads();
}

DI void attn_qk_prep(bf16_t* U, const float* qg, const float* kg, const float* RP, int tid, bf16_t* DST = nullptr) {
    const int sub = tid & 7, grp = (tid >> 3) & 15, rib = tid >> 7;
    float gg[8];
#pragma unroll
    for (int j = 0; j < 8; ++j) gg[j] = ((grp < 8) ? qg : kg)[sub * 8 + j];
    for (int m0 = blockIdx.x * 32 + rib; m0 < M; m0 += gridDim.x * 32) {
        u32x4 w[8];
#pragma unroll
        for (int i = 0; i < 8; ++i) w[i] = *(const u32x4*)(U + (size_t)(m0 + 4 * i) * NU + U_AQ + grp * 64 + sub * 8);
#pragma unroll
        for (int i = 0; i < 8; ++i) {
            const int m = m0 + 4 * i; float f[8]; unpack8(w[i], f);
            float ss = 0.f;
#pragma unroll
            for (int j = 0; j < 8; ++j) ss += f[j] * f[j];
            ss += __shfl_xor(ss, 1); ss += __shfl_xor(ss, 2); ss += __shfl_xor(ss, 4);
            const float rstd = __builtin_amdgcn_rsqf(ss * (1.f / 64) + EPS);
#pragma unroll
            for (int j = 0; j < 8; ++j) f[j] = f[j] * rstd * gg[j];
            const int pos = m & (T - 1);
            float oth[8];
#pragma unroll
            for (int j = 0; j < 8; ++j) oth[j] = __shfl_xor(f[j], 1);
            if (sub < 2) {
                const float* rp = RP + (size_t)pos * 16;
#pragma unroll
                for (int j = 0; j < 8; ++j) { const float c = rp[2 * j], s = rp[2 * j + 1]; f[j] = (sub == 0) ? (f[j] * c - oth[j] * s) : (f[j] * c + oth[j] * s); }
            }
            if (grp < 8) {
#pragma unroll
                for (int j = 0; j < 8; ++j) f[j] *= 0.125f * LOG2E;
            }
            if (DST) *(u32x4*)(DST + (size_t)m * D + grp * 64 + sub * 8) = pack8f(f); else *(u32x4*)(U + (size_t)m * NU + U_AQ + grp * 64 + sub * 8) = pack8f(f);
        }
    }
}
typedef short v4i16_t __attribute__((ext_vector_type(4)));
typedef __attribute__((address_space(3))) const unsigned char* lds_cp;
DI s16x4 tr_rd(lds_cp p) { return __builtin_bit_cast(s16x4, __builtin_amdgcn_ds_read_tr16_b64_v4i16((__attribute__((address_space(3))) v4i16_t*)p)); }
template <bool PERMK> DI bf16x8 tr_frag(lds_cp img, int pitchB, int k0, int m0, int lane) {
    const int h = lane >> 5, q = (lane & 15) >> 2, p = lane & 3, blk = (lane >> 4) & 1;
    const int kl = PERMK ? (k0 + 4 * h + q) : (k0 + 8 * h + q), kh = PERMK ? (kl + 8) : (kl + 4);
    const int cb = (m0 + 16 * blk + 4 * p) * 2;
    const s16x4 lo = tr_rd(img + kl * pitchB + cb), hi = tr_rd(img + kh * pitchB + cb);
    return __builtin_shufflevector(lo, hi, 0, 1, 2, 3, 4, 5, 6, 7);
}
constexpr int AT_KB = 18432, AT_VB = 18432, AT_BUF = AT_KB + AT_VB;
constexpr int AT_OX = 0, AT_OS = 2 * AT_BUF;
DI void attn_unit(const bf16_t* U, bf16_t* MIX, int b, int hd, int qb, float lam, float osc, const float* subg, unsigned char* lds, int tid_in) {
    int tid = tid_in; asm volatile("" : "+v"(tid));
    const int lane = tid & 63, r = lane & 31, h = lane >> 5, w = __builtin_amdgcn_readfirstlane(tid >> 6), c = w >> 2, wq = w & 3;
    float* OX = (float*)(lds + AT_OX); bf16_t* OS = (bf16_t*)(lds + AT_OS);
    const lds_cp lds3 = (lds_cp)lds;
    const size_t rowbase = (size_t)b * T; const int q0 = qb * 128; const int NT = 2 * qb + 2;
    bf16x8 qf[4];
    { const bf16_t* qp = U + (rowbase + q0 + 32 * wq + r) * NU + U_AQ + hd * 128 + c * 64 + 8 * h;
#pragma unroll
      for (int ks = 0; ks < 4; ++ks) qf[ks] = ld8(qp + 16 * ks); }
    u32x4 kreg[2], vreg[2];
#define AT_PREFETCH(kt) do { _Pragma("unroll") for (int i_ = 0; i_ < 2; ++i_) { const int id_ = tid + 512 * i_, key_ = id_ >> 4, ch_ = id_ & 15; \
        const bf16_t* rp_ = U + (rowbase + 64 * (kt) + key_) * NU + hd * 128 + ch_ * 8; kreg[i_] = *(const u32x4*)(rp_ + U_AK); vreg[i_] = *(const u32x4*)(rp_ + U_AV); } } while (0)
#define AT_STORE(buf) do { unsigned char* kb_ = lds + (buf) * AT_BUF; _Pragma("unroll") for (int i_ = 0; i_ < 2; ++i_) { const int id_ = tid + 512 * i_, key_ = id_ >> 4, ch_ = id_ & 15; \
        *(u32x4*)(kb_ + (((ch_ >> 3) * 64 + key_) * 72 + (ch_ & 7) * 8) * 2) = kreg[i_]; *(u32x4*)(kb_ + AT_KB + (key_ * 144 + ch_ * 8) * 2) = vreg[i_]; } } while (0)
    AT_PREFETCH(0);
    __syncthreads();
    AT_STORE(0);
    if (NT > 1) AT_PREFETCH(1);
    float m_ref = 0.f, l_run = 0.f; f32x16 o[4]; f32x16 negm;
#pragma unroll
    for (int e = 0; e < 16; ++e) negm[e] = 0.f;
#pragma unroll
    for (int vb = 0; vb < 4; ++vb)
#pragma unroll
        for (int e = 0; e < 16; ++e) o[vb][e] = 0.f;
    const int qpos = q0 + 32 * wq + r;
    __syncthreads();
    if (w >= 4) __builtin_amdgcn_s_setprio(1);
    for (int kt = 0; kt < NT; ++kt) {
        const int cur = kt & 1;
        if (kt + 1 < NT) { AT_STORE(cur ^ 1); if (kt + 2 < NT) AT_PREFETCH(kt + 2); }
        const bf16_t* KS = (const bf16_t*)(lds + cur * AT_BUF); const lds_cp VS = lds3 + cur * AT_BUF + AT_KB;
        if (kt != NT - 1 || wq >= 2) {
        f32x16 st[2];
        {
            bf16x8 kf[2][4];
#pragma unroll
            for (int nb = 0; nb < 2; ++nb)
#pragma unroll
                for (int ks = 0; ks < 4; ++ks) kf[nb][ks] = ld8(KS + (c * 64 + 32 * nb + r) * 72 + 16 * ks + 8 * h);
            __builtin_amdgcn_sched_barrier(0);
#pragma unroll
            for (int nb = 0; nb < 2; ++nb) {
                st[nb] = MFMA32(kf[nb][0], qf[0], negm);
#pragma unroll
                for (int ks = 1; ks < 4; ++ks) st[nb] = MFMA32(kf[nb][ks], qf[ks], st[nb]); }
        }
        if (kt >= 2 * qb) {
            asm volatile("" ::: "memory");
#pragma unroll
            for (int nb = 0; nb < 2; ++nb)
#pragma unroll
                for (int e = 0; e < 16; ++e) { const int key = 64 * kt + 32 * nb + crow(e, h); if (key > qpos) st[nb][e] = -1e30f; } }
        float mx = st[0][0];
#pragma unroll
        for (int nb = 0; nb < 2; ++nb)
#pragma unroll
            for (int e = 0; e < 16; ++e) mx = fmaxf(mx, st[nb][e]);
        { const auto rr_ = __builtin_amdgcn_permlane32_swap(__float_as_uint(mx), __float_as_uint(mx), false, false); mx = fmaxf(__uint_as_float(rr_[0]), __uint_as_float(rr_[1])); }
        if (kt == 0 || __any(mx > 8.0f)) {
            const float delta = (kt == 0) ? mx : fmaxf(mx, 0.f); const float alpha = __builtin_amdgcn_exp2f(-delta); m_ref += delta; l_run *= alpha;
#pragma unroll
            for (int nb = 0; nb < 2; ++nb)
#pragma unroll
                for (int e = 0; e < 16; ++e) st[nb][e] -= delta;
#pragma unroll
            for (int e = 0; e < 16; ++e) negm[e] = -m_ref;
#pragma unroll
            for (int vb = 0; vb < 4; ++vb)
#pragma unroll
                for (int e = 0; e < 16; ++e) o[vb][e] *= alpha;
        }
        f32x2_t ps2 = {0.f, 0.f};
#pragma unroll
        for (int e = 0; e < 16; e += 2) { const float p0 = __builtin_amdgcn_exp2f(st[0][e]), p1 = __builtin_amdgcn_exp2f(st[0][e + 1]); st[0][e] = p0; st[0][e + 1] = p1; ps2 += (f32x2_t){p0, p1}; }
        {
            bf16x8 va[8], vn[8];
#pragma unroll
            for (int i = 0; i < 8; ++i) va[i] = tr_frag<true>(VS, 288, 16 * (i >> 2), 32 * (i & 3), lane);
            const bf16x8 pfa = pack8(st[0], 0), pfb = pack8(st[0], 1);
            __builtin_amdgcn_sched_barrier(0);
#pragma unroll
            for (int i = 0; i < 8; ++i) {
                o[i & 3] = MFMA32(va[i], (i < 4) ? pfa : pfb, o[i & 3]);
                vn[i] = tr_frag<true>(VS, 288, 32 + 16 * (i >> 2), 32 * (i & 3), lane);
                { const int e2 = 2 * i; const float p0 = __builtin_amdgcn_exp2f(st[1][e2]), p1 = __builtin_amdgcn_exp2f(st[1][e2 + 1]); st[1][e2] = p0; st[1][e2 + 1] = p1; ps2 += (f32x2_t){p0, p1}; }
                __builtin_amdgcn_sched_barrier(0);
            }
            l_run += ps2.x + ps2.y;
            const bf16x8 pfc = pack8(st[1], 0), pfd = pack8(st[1], 1);
            __builtin_amdgcn_sched_barrier(0);
#pragma unroll
            for (int i = 0; i < 8; ++i) o[i & 3] = MFMA32(vn[i], (i < 4) ? pfc : pfd, o[i & 3]);
        }
        }
        lds_barrier();
    }
#undef AT_PREFETCH
#undef AT_STORE
    __builtin_amdgcn_s_setprio(0);
    const float l_tot = l_run + __shfl_xor(l_run, 32); const float inv_l = __builtin_amdgcn_rcpf(l_tot);
    if (c == 1) {
#pragma unroll
        for (int vb = 0; vb < 4; ++vb)
#pragma unroll
            for (int e = 0; e < 16; ++e) OX[(wq * 32 + r) * 129 + 32 * vb + crow(e, h)] = o[vb][e] * inv_l; }
    __syncthreads();
    if (c == 0) {
        float ss = 0.f;
#pragma unroll
        for (int vb = 0; vb < 4; ++vb)
#pragma unroll
            for (int e = 0; e < 16; ++e) { const float v = o[vb][e] * inv_l - lam * OX[(wq * 32 + r) * 129 + 32 * vb + crow(e, h)]; o[vb][e] = v; ss += v * v; }
        ss += __shfl_xor(ss, 32);
        const float rn = osc * __builtin_amdgcn_rsqf(ss * (1.f / 128) + EPS);
#pragma unroll
        for (int vb = 0; vb < 4; ++vb)
#pragma unroll
            for (int e = 0; e < 16; ++e) { const int v = 32 * vb + crow(e, h); OS[(wq * 32 + r) * 136 + v] = (bf16_t)f2bf(o[vb][e] * rn * subg[v]); }
    }
    __syncthreads();
    if (c == 0) {
#pragma unroll
        for (int i = 0; i < 8; ++i) { const int idx = i * 64 + lane, row = idx >> 4, ch = idx & 15;
            const u32x4 v = *(const u32x4*)(OS + (wq * 32 + row) * 136 + ch * 8);
            *(u32x4*)(MIX + (rowbase + q0 + 32 * wq + row) * D + 256 + hd * 128 + ch * 8) = v; }
    }
}
constexpr int ML_Q = 0, ML_K = 18432, ML_WK = 36864, ML_V = 55296, ML_C = 73728, ML_H = 82944, ML_AR = 116224, ML_N = 118272, ML_CW = 118528, ML_CF = 120576, ML_NG = 137216;
DI float logsigf_(float x) { return fminf(x, 0.f) - __logf(1.f + __expf(-fabsf(x))); }
DI void mlstm_unit(const bf16_t* U, const float* GATE, bf16_t* MIX, const float* convw, const float* ng, int b, int hd, unsigned char* lds, int tid_in) {
    int tid = tid_in; asm volatile("" : "+v"(tid));
    const int lane = tid & 63, r = lane & 31, h = lane >> 5, w = __builtin_amdgcn_readfirstlane(tid >> 6);
    bf16_t* Q = (bf16_t*)(lds + ML_Q); bf16_t* K = (bf16_t*)(lds + ML_K); bf16_t* WK = (bf16_t*)(lds + ML_WK); bf16_t* VV = (bf16_t*)(lds + ML_V);
    bf16_t* CL = (bf16_t*)(lds + ML_C); float* H = (float*)(lds + ML_H); float* AR = (float*)(lds + ML_AR); float* NV = (float*)(lds + ML_N); float* CW = (float*)(lds + ML_CW);
    float* rowt = AR; float* colt = AR + 128; float* scl = AR + 256; float* dfl = AR + 384;
    const lds_cp lds3 = (lds_cp)lds;
    const size_t rowbase = (size_t)b * T;
    __syncthreads();
    { const int j = tid >> 7, ch = tid & 127; CW[j * 128 + ch] = convw[j * 512 + (ch < 64 ? hd * 64 + ch : 256 + hd * 64 + (ch - 64))]; }
    float* NG = (float*)(lds + ML_NG);
    if (tid < 64) { NV[tid] = 0.f; NG[tid] = ng[tid]; }
    for (int i = tid; i < 64 * 72; i += NTHREADS) CL[i] = 0;
    float* CF = (float*)(lds + ML_CF);
    for (int i = tid; i < 64 * 65; i += NTHREADS) CF[i] = 0.f;
    float mprev = 0.f;
    const int cch = tid & 15, rblk = tid >> 4;
    const int ccol = (cch < 8) ? (U_MQ + hd * 64 + cch * 8) : (U_MK + hd * 64 + (cch - 8) * 8);
    const int ft = tid >> 2, fv0 = (tid & 3) * 16;
    u32x4 ncr[7]; float ngt[4];
#define ML_PREFETCH(c_) do { const int t0_ = 128 * (c_); \
        _Pragma("unroll") for (int j_ = 0; j_ < 7; ++j_) { const int tt_ = t0_ + 4 * rblk - 3 + j_; ncr[j_] = (tt_ >= 0) ? *(const u32x4*)(U + (rowbase + tt_) * NU + ccol) : (u32x4){0u, 0u, 0u, 0u}; } \
        { const float* gp_ = GATE + (rowbase + t0_ + 2 * lane) * 8; ngt[0] = gp_[hd]; ngt[1] = gp_[4 + hd]; ngt[2] = gp_[8 + hd]; ngt[3] = gp_[12 + hd]; } } while (0)
    ML_PREFETCH(0);
    for (int c = 0; c < T / 128; ++c) {
        const int t0 = 128 * c;
        u32x4 cr[7], vr[2], orw[2];
#pragma unroll
        for (int j = 0; j < 7; ++j) cr[j] = ncr[j];
#pragma unroll
        for (int i = 0; i < 2; ++i) { const int id = tid + 512 * i; vr[i] = *(const u32x4*)(U + (rowbase + t0 + (id >> 3)) * NU + U_MV + hd * 64 + (id & 7) * 8); }
        const float ig0 = ngt[0], fg0 = ngt[1], ig1 = ngt[2], fg1 = ngt[3];
        const float lf0 = logsigf_(fg0), lf1 = logsigf_(fg1);
        const float ps = lf0 + lf1; float incl = ps;
#pragma unroll
        for (int o = 1; o < 64; o <<= 1) { const float t_ = __shfl_up(incl, o); if (lane >= o) incl += t_; }
        const float b0 = incl - ps + lf0, b1 = incl;
        const float a0 = ig0 - b0, a1 = ig1 - b1;
        float cmi = fmaxf(a0, a1);
#pragma unroll
        for (int o = 1; o < 64; o <<= 1) { const float t_ = __shfl_up(cmi, o); if (lane >= o) cmi = fmaxf(cmi, t_); }
        float cme = __shfl_up(cmi, 1); if (lane == 0) cme = -3.0e38f;
        const float cm0 = fmaxf(cme, a0), cm1 = cmi;
        const float amax = __shfl(cmi, 63), bL = __shfl(incl, 63);
        const float M0 = fmaxf(cm0, mprev), M1 = fmaxf(cm1, mprev), Mx = fmaxf(mprev, amax);
        const float wv0 = __expf(a0 - Mx), wv1 = __expf(a1 - Mx);
        const float dec = __expf(mprev - Mx);
        if (w == 0) {
            rowt[2 * lane] = -M0 * LOG2E; rowt[2 * lane + 1] = -M1 * LOG2E;
            colt[2 * lane] = a0 * LOG2E; colt[2 * lane + 1] = a1 * LOG2E;
            scl[2 * lane] = __expf(mprev - M0); scl[2 * lane + 1] = __expf(mprev - M1);
            dfl[2 * lane] = __expf(-(b0 + M0)); dfl[2 * lane + 1] = __expf(-(b1 + M1));
        }
        mprev = bL + Mx;
        {
            const float w0 = __shfl(wv0, 2 * (rblk & 31)), w1 = __shfl(wv1, 2 * (rblk & 31)), w2 = __shfl(wv0, 2 * (rblk & 31) + 1), w3 = __shfl(wv1, 2 * (rblk & 31) + 1);
            const float wts[4] = {w0, w1, w2, w3};
            const float ksc = (cch < 8) ? 1.0f : 0.125f;
            u32x4 opk[4], wpk[4];
#pragma unroll
            for (int p = 0; p < 4; ++p) {
                float xl[7], xh[7], cl[4], chh[4];
#pragma unroll
                for (int j = 0; j < 7; ++j) { const unsigned wd = cr[j][p]; xl[j] = __builtin_bit_cast(float, wd << 16); xh[j] = __builtin_bit_cast(float, wd & 0xffff0000u); }
#pragma unroll
                for (int j = 0; j < 4; ++j) { const f32x2_t c2 = *(const f32x2_t*)(CW + j * 128 + cch * 8 + 2 * p); cl[j] = c2.x; chh[j] = c2.y; }
#pragma unroll
                for (int i = 0; i < 4; ++i) {
                    float sl = cl[0] * xl[i] + cl[1] * xl[i + 1] + cl[2] * xl[i + 2] + cl[3] * xl[i + 3];
                    float sh = chh[0] * xh[i] + chh[1] * xh[i + 1] + chh[2] * xh[i + 2] + chh[3] * xh[i + 3];
                    sl = sl * sigmoidf_(sl) * ksc; sh = sh * sigmoidf_(sh) * ksc;
                    opk[i][p] = cvtpk(sl, sh); wpk[i][p] = cvtpk(sl * wts[i], sh * wts[i]);
                }
            }
            bf16_t* dst = ((cch < 8) ? Q : K) + (4 * rblk) * 72 + (cch & 7) * 8;
#pragma unroll
            for (int i = 0; i < 4; ++i) { *(u32x4*)(dst + i * 72) = opk[i]; if (cch >= 8) *(u32x4*)(WK + (4 * rblk + i) * 72 + (cch - 8) * 8) = wpk[i]; }
#pragma unroll
            for (int i = 0; i < 2; ++i) { const int id = tid + 512 * i; *(u32x4*)(VV + (id >> 3) * 72 + (id & 7) * 8) = vr[i]; }
        }
        lds_barrier();
#pragma unroll
        for (int i = 0; i < 2; ++i) orw[i] = *(const u32x4*)(U + (rowbase + t0 + ft) * NU + U_MO + hd * 64 + fv0 + 8 * i);
        {
            const int vb = w & 1, tb = (w < 4) ? (w >> 1) : (3 - ((w - 4) >> 1)), t = 32 * tb + r;
            bf16x8 qf[4];
#pragma unroll
            for (int ks = 0; ks < 4; ++ks) qf[ks] = ld8(Q + t * 72 + 16 * ks + 8 * h);
            f32x16 acc;
#pragma unroll
            for (int e = 0; e < 16; ++e) acc[e] = 0.f;
#pragma unroll
            for (int ks = 0; ks < 4; ++ks) { const bf16x8 a = ld8(CL + (32 * vb + r) * 72 + 16 * ks + 8 * h); acc = MFMA32(a, qf[ks], acc); }
            const float sc = scl[t], rt = rowt[t];
#pragma unroll
            for (int e = 0; e < 16; ++e) acc[e] *= sc;
            float dn = 0.f;
#pragma unroll
            for (int ks = 0; ks < 4; ++ks)
#pragma unroll
                for (int j = 0; j < 8; ++j) dn += bf2f((unsigned short)qf[ks][j]) * NV[16 * ks + 8 * h + j];
            dn += __shfl_xor(dn, 32);
            float dsum = 0.f;
#pragma unroll
            for (int sb = 0; sb < 4; ++sb) {
                if (sb <= tb) {
                    f32x16 st;
#pragma unroll
                    for (int e = 0; e < 16; ++e) st[e] = 0.f;
#pragma unroll
                    for (int ks = 0; ks < 4; ++ks) { const bf16x8 a = ld8(K + (32 * sb + r) * 72 + 16 * ks + 8 * h); st = MFMA32(a, qf[ks], st); }
#pragma unroll
                    for (int e = 0; e < 16; ++e) { const int sl = crow(e, h); float v = st[e] * __builtin_amdgcn_exp2f(rt + colt[32 * sb + sl]); if (sb == tb && sl > r) v = 0.f; st[e] = v; dsum += v; }
#pragma unroll
                    for (int s2 = 0; s2 < 2; ++s2) { const bf16x8 pf = pack8(st, s2); const bf16x8 a = tr_frag<true>(lds3 + ML_V, 144, 32 * sb + 16 * s2, 32 * vb, lane); acc = MFMA32(a, pf, acc); }
                }
            }
            dsum += __shfl_xor(dsum, 32);
            const float den = dsum + sc * dn;
            const float inv = __builtin_amdgcn_rcpf(fmaxf(fabsf(den), dfl[t]));
#pragma unroll
            for (int e = 0; e < 16; ++e) H[t * 65 + 32 * vb + crow(e, h)] = acc[e] * inv;
        }
        lds_barrier();
        if (c + 1 < T / 128) ML_PREFETCH(c + 1);
        {
            float hv[16]; float ss = 0.f;
#pragma unroll
            for (int e = 0; e < 16; ++e) { hv[e] = H[ft * 65 + fv0 + e]; ss += hv[e] * hv[e]; }
            ss += __shfl_xor(ss, 1); ss += __shfl_xor(ss, 2);
            const float rn = __builtin_amdgcn_rsqf(ss * (1.f / 64) + EPS);
            bf16_t* mp = MIX + (rowbase + t0 + ft) * D + hd * 64 + fv0;
#pragma unroll
            for (int g = 0; g < 2; ++g) { float og[8]; unpack8(orw[g], og); float ov2[8];
#pragma unroll
                for (int e = 0; e < 8; ++e) ov2[e] = hv[8 * g + e] * rn * NG[fv0 + 8 * g + e] * sigmoidf_(og[e]);
                *(u32x4*)(mp + 8 * g) = pack8f(ov2); }
        }
        if (w < 4) {
            const int vb2 = w & 1, kb2 = w >> 1;
            f32x16 cacc;
#pragma unroll
            for (int e = 0; e < 16; ++e) cacc[e] = CF[(32 * vb2 + crow(e, h)) * 65 + 32 * kb2 + r] * dec;
#pragma unroll
            for (int s2 = 0; s2 < 8; ++s2) { const bf16x8 a = tr_frag<false>(lds3 + ML_V, 144, 16 * s2, 32 * vb2, lane); const bf16x8 bb = tr_frag<false>(lds3 + ML_WK, 144, 16 * s2, 32 * kb2, lane); cacc = MFMA32(a, bb, cacc); }
#pragma unroll
            for (int e = 0; e < 16; ++e) { CF[(32 * vb2 + crow(e, h)) * 65 + 32 * kb2 + r] = cacc[e]; CL[(32 * vb2 + crow(e, h)) * 72 + 32 * kb2 + r] = (bf16_t)f2bf(cacc[e]); }
        } else if (w < 6) {
            const int kb2 = w - 4; const bf16x8 ones = {0x3f80, 0x3f80, 0x3f80, 0x3f80, 0x3f80, 0x3f80, 0x3f80, 0x3f80};
            f32x16 nacc;
#pragma unroll
            for (int e = 0; e < 16; ++e) nacc[e] = 0.f;
#pragma unroll
            for (int s2 = 0; s2 < 8; ++s2) { const bf16x8 bb = tr_frag<false>(lds3 + ML_WK, 144, 16 * s2, 32 * kb2, lane); nacc = MFMA32(ones, bb, nacc); }
            if (h == 0) NV[32 * kb2 + r] = dec * NV[32 * kb2 + r] + nacc[0];
        }
        lds_barrier();
    }
#undef ML_PREFETCH
}
constexpr int HG_TOT = 0, HG_Q0 = 2048, HG_QD = 11264, HG_KD = 20480, HG_KE = 29696, HG_V = 38912, HG_ST = 48128, HG_OH = 66560;
DI void hgrn_unit(const bf16_t* U, bf16_t* MIX, const float* LBl, const float* hn, int b, int hd, unsigned char* lds, int tid_in) {
    int tid = tid_in; asm volatile("" : "+v"(tid));
    const int lane = tid & 63, r = lane & 31, h = lane >> 5, w = __builtin_amdgcn_readfirstlane(tid >> 6);
    float* TOT = (float*)(lds + HG_TOT); bf16_t* Q0 = (bf16_t*)(lds + HG_Q0); bf16_t* QD = (bf16_t*)(lds + HG_QD); bf16_t* KD = (bf16_t*)(lds + HG_KD);
    bf16_t* KE = (bf16_t*)(lds + HG_KE); bf16_t* VV = (bf16_t*)(lds + HG_V); bf16_t* ST = (bf16_t*)(lds + HG_ST); float* OH = (float*)(lds + HG_OH);
    const lds_cp lds3 = (lds_cp)lds;
    const size_t rowbase = (size_t)b * T;
    __syncthreads();
    for (int i = tid; i < 64 * 72; i += NTHREADS) ST[i] = 0;
    f32x16 sacc;
#pragma unroll
    for (int e = 0; e < 16; ++e) sacc[e] = 0.f;
    const int tA = tid >> 3, k0 = (tid & 7) * 8;
    float lbv[8], hnv[8];
#pragma unroll
    for (int e = 0; e < 8; ++e) { lbv[e] = LBl[hd * 64 + k0 + e]; hnv[e] = hn[k0 + e]; }
    u32x4 nq, nf, nv, ng;
#define HG_PREFETCH(c_) do { const bf16_t* rp_ = U + (rowbase + 64 * (c_) + tA) * NU + hd * 64 + k0; nq = *(const u32x4*)(rp_ + U_HQ); nf = *(const u32x4*)(rp_ + U_HF); nv = *(const u32x4*)(rp_ + U_HI); ng = *(const u32x4*)(rp_ + U_HG); } while (0)
    HG_PREFETCH(0);
    int cur = 0;
    for (int c = 0; c < T / 64; ++c) {
        const size_t row = rowbase + 64 * c + tA;
        const u32x4 qw = nq, fw = nf, vw = nv, gw = ng;
        if (c + 1 < T / 64) HG_PREFETCH(c + 1);
        float qv[8], kk[8], bc[8];
        { float qp[8], fp[8]; unpack8(qw, qp); unpack8(fw, fp);
#pragma unroll
          for (int e = 0; e < 8; ++e) { qv[e] = qp[e] * sigmoidf_(qp[e]); const float ex = __expf(-fp[e]); const float sg = __builtin_amdgcn_rcpf(1.f + ex), sn = ex * sg;
              bc[e] = __logf(lbv[e] + (1.f - lbv[e]) * sg); kk[e] = (1.f - lbv[e]) * sn; } }
#pragma unroll
        for (int o = 8; o < 64; o <<= 1) {
#pragma unroll
            for (int e = 0; e < 8; ++e) { const float t_ = __shfl_up(bc[e], o); if (lane >= o) bc[e] += t_; } }
        if ((lane >> 3) == 7) { *(f32x4*)(TOT + w * 64 + k0) = (f32x4){bc[0], bc[1], bc[2], bc[3]}; *(f32x4*)(TOT + w * 64 + k0 + 4) = (f32x4){bc[4], bc[5], bc[6], bc[7]}; }
        *(u32x4*)(VV + tA * 72 + k0) = vw;
        lds_barrier();
        float r1[8], bl[8];
        {
#pragma unroll
            for (int e = 0; e < 8; ++e) { r1[e] = 0.f; bl[e] = 0.f; }
            float pre[8];
#pragma unroll
            for (int e = 0; e < 8; ++e) pre[e] = 0.f;
#pragma unroll
            for (int w2 = 0; w2 < 8; ++w2) { const f32x4 a = *(const f32x4*)(TOT + w2 * 64 + k0), c4 = *(const f32x4*)(TOT + w2 * 64 + k0 + 4);
                const float tv[8] = {a.x, a.y, a.z, a.w, c4.x, c4.y, c4.z, c4.w};
#pragma unroll
                for (int e = 0; e < 8; ++e) { if (w2 < w) pre[e] += tv[e]; if (w2 < 4) r1[e] += tv[e]; bl[e] += tv[e]; } }
#pragma unroll
            for (int e = 0; e < 8; ++e) bc[e] += pre[e];
        }
        {
            float q0[8], qd[8], kd[8], ke[8];
#pragma unroll
            for (int e = 0; e < 8; ++e) { const float rr = (w >= 4) ? r1[e] : 0.f;
                q0[e] = qv[e] * __expf(bc[e]); qd[e] = qv[e] * __expf(bc[e] - rr); kd[e] = kk[e] * __expf(rr - bc[e]); ke[e] = kk[e] * __expf(bl[e] - bc[e]); }
            *(u32x4*)(Q0 + tA * 72 + k0) = pack8f(q0); *(u32x4*)(QD + tA * 72 + k0) = pack8f(qd); *(u32x4*)(KD + tA * 72 + k0) = pack8f(kd); *(u32x4*)(KE + tA * 72 + k0) = pack8f(ke);
        }
        lds_barrier();
        if (w < 4) {
            const int vb = w & 1, tb = w >> 1, t = 32 * tb + r;
            bf16x8 qf0[4], qfd[4];
#pragma unroll
            for (int ks = 0; ks < 4; ++ks) { qf0[ks] = ld8(Q0 + t * 72 + 16 * ks + 8 * h); qfd[ks] = ld8(QD + t * 72 + 16 * ks + 8 * h); }
            f32x16 acc;
#pragma unroll
            for (int e = 0; e < 16; ++e) acc[e] = 0.f;
            const bf16_t* STc = ST + cur * 64 * 72;
#pragma unroll
            for (int ks = 0; ks < 4; ++ks) { const bf16x8 a = ld8(STc + (32 * vb + r) * 72 + 16 * ks + 8 * h); acc = MFMA32(a, qf0[ks], acc); }
#pragma unroll
            for (int sb = 0; sb < 2; ++sb) {
                if (sb <= tb) {
                    f32x16 st;
#pragma unroll
                    for (int e = 0; e < 16; ++e) st[e] = 0.f;
#pragma unroll
                    for (int ks = 0; ks < 4; ++ks) { const bf16x8 a = ld8(KD + (32 * sb + r) * 72 + 16 * ks + 8 * h); st = MFMA32(a, (sb == tb) ? qfd[ks] : qf0[ks], st); }
                    if (sb == tb) {
#pragma unroll
                        for (int e = 0; e < 16; ++e) if (crow(e, h) > r) st[e] = 0.f; }
#pragma unroll
                    for (int s2 = 0; s2 < 2; ++s2) { const bf16x8 pf = pack8(st, s2); const bf16x8 a = tr_frag<true>(lds3 + HG_V, 144, 32 * sb + 16 * s2, 32 * vb, lane); acc = MFMA32(a, pf, acc); }
                }
            }
#pragma unroll
            for (int e = 0; e < 16; ++e) OH[t * 65 + 32 * vb + crow(e, h)] = acc[e];
        } else {
            const int vb = w & 1, kb = (w >> 1) & 1;
            float dsum = 0.f;
#pragma unroll
            for (int w2 = 0; w2 < 8; ++w2) dsum += TOT[w2 * 64 + 32 * kb + r];
            const float dec = __expf(dsum);
#pragma unroll
            for (int e = 0; e < 16; ++e) sacc[e] *= dec;
#pragma unroll
            for (int s2 = 0; s2 < 4; ++s2) { const bf16x8 a = tr_frag<false>(lds3 + HG_V, 144, 16 * s2, 32 * vb, lane); const bf16x8 bb = tr_frag<false>(lds3 + HG_KE, 144, 16 * s2, 32 * kb, lane); sacc = MFMA32(a, bb, sacc); }
            bf16_t* STn = ST + (cur ^ 1) * 64 * 72;
#pragma unroll
            for (int e = 0; e < 16; ++e) STn[(32 * vb + crow(e, h)) * 72 + 32 * kb + r] = (bf16_t)f2bf(sacc[e]);
        }
        lds_barrier();
        {
            float ov[8]; float ss = 0.f;
#pragma unroll
            for (int e = 0; e < 8; ++e) { ov[e] = OH[tA * 65 + k0 + e]; ss += ov[e] * ov[e]; }
            ss += __shfl_xor(ss, 1); ss += __shfl_xor(ss, 2); ss += __shfl_xor(ss, 4);
            const float rn = __builtin_amdgcn_rsqf(ss * (1.f / 64) + EPS);
            float gp[8]; unpack8(gw, gp);
#pragma unroll
            for (int e = 0; e < 8; ++e) ov[e] = ov[e] * rn * hnv[e] * (gp[e] * sigmoidf_(gp[e]));
            *(u32x4*)(MIX + row * D + 768 + hd * 64 + k0) = pack8f(ov);
        }
        cur ^= 1;
    }
#undef HG_PREFETCH
    __syncthreads();
}
#define LAS __attribute__((address_space(3)))
#define XB_TMO      128
#define XB_XCNT(j)  (256  + 64 * (j))
#define XB_XSUB(j)  (1280 + 64 * (j))
#define XB_XGEN(j)  (2304 + 64 * (j))
#define XB_TOP      3328
#define XB_TOPGEN   3392
#define XCD_BAR_WORDS 3456
#define XB_SPIN_CAP (1u << 18)

__device__ __forceinline__ unsigned xb_ld(unsigned* p)              { return __hip_atomic_load(p, __ATOMIC_RELAXED, __HIP_MEMORY_SCOPE_AGENT); }
__device__ __forceinline__ unsigned xb_add(unsigned* p, unsigned v) { return __hip_atomic_fetch_add(p, v, __ATOMIC_RELAXED, __HIP_MEMORY_SCOPE_AGENT); }
__device__ __forceinline__ unsigned xb_xcc_id() { return (unsigned)__builtin_amdgcn_s_getreg((3 << 11) | 20) & 0xFu; }
#define XB_SPIN(cond, bar) do { unsigned _sp = 0; while (cond) { __builtin_amdgcn_s_sleep(1); \
    if ((++_sp & 255u) == 0u) { if (xb_ld(&(bar)[XB_TMO])) break; if (_sp > XB_SPIN_CAP) { atomicAdd(&(bar)[XB_TMO], 1u); break; } } } } while (0)

struct XcdBarrier {
    unsigned* bar; unsigned x;
    volatile LAS unsigned* st;
};

__device__ __forceinline__ XcdBarrier xcd_barrier_post(unsigned* bar, volatile LAS unsigned* st) {
    XcdBarrier b; b.bar = bar; b.x = xb_xcc_id(); b.st = st;
    if (threadIdx.x == 0) (void)xb_add(&bar[XB_XCNT(b.x)], 1u);
    return b;
}
__device__ __forceinline__ void xcd_barrier_complete(unsigned* bar, unsigned x, unsigned& nloc, unsigned& nx) {
    const unsigned G = gridDim.x * gridDim.y * gridDim.z;
    unsigned sum, cnt, mine, sp = 0u;
    for (;;) {
        sum = 0u; cnt = 0u; mine = 0u;
#pragma unroll
        for (unsigned j = 0; j < 16; ++j) { const unsigned c = xb_ld(&bar[XB_XCNT(j)]); sum += c; cnt += (c > 0u) ? 1u : 0u; mine = (j == x) ? c : mine; }
        if (sum == G) break;
        __builtin_amdgcn_s_sleep(1);
        if ((++sp & 255u) == 0u) { if (xb_ld(&bar[XB_TMO])) break; if (sp > XB_SPIN_CAP) { atomicAdd(&bar[XB_TMO], 1u); break; } }
    }
    nloc = mine > 0u ? mine : 1u; nx = cnt > 0u ? cnt : 1u;
}

__device__ __forceinline__ void xcd_barrier(const XcdBarrier& b, int tid_in) {
    asm volatile("s_waitcnt vmcnt(0)" ::: "memory");
    __syncthreads();
    if (tid_in == 0) {
        unsigned* bar = b.bar;
        __builtin_amdgcn_s_waitcnt(0);
        unsigned nloc = b.st[0], nx = b.st[1];
        if (nloc == 0u) { xcd_barrier_complete(bar, b.x, nloc, nx); b.st[0] = nloc; b.st[1] = nx; }
        const unsigned old = xb_add(&bar[XB_XSUB(b.x)], 1u);
        const unsigned gen = old / nloc;
        if (old + 1u == (gen + 1u) * nloc) {
            __builtin_amdgcn_fence(__ATOMIC_RELEASE, "agent");
            asm volatile("s_waitcnt vmcnt(0)" ::: "memory");
            const unsigned og = xb_add(&bar[XB_TOP], 1u);
            const unsigned tg = og / nx;
            if (og + 1u == (tg + 1u) * nx) xb_add(&bar[XB_TOPGEN], 1u);
            else XB_SPIN(xb_ld(&bar[XB_TOPGEN]) == tg, bar);
            __builtin_amdgcn_fence(__ATOMIC_ACQUIRE, "agent");
            xb_add(&bar[XB_XGEN(b.x)], 1u);
            asm volatile("s_waitcnt vmcnt(0)" ::: "memory");
        } else {
            XB_SPIN(xb_ld(&bar[XB_XGEN(b.x)]) == gen, bar);
            __builtin_amdgcn_fence(__ATOMIC_ACQUIRE, "agent");
            asm volatile("s_waitcnt vmcnt(0)" ::: "memory");
        }
    }
    __syncthreads();
}

#ifdef NO_G1
#define GC1 if (0)
#else
#define GC1
#endif
#ifdef NO_G2
#define GC2 if (0)
#else
#define GC2
#endif
#ifdef NO_G3
#define GC3 if (0)
#else
#define GC3
#endif
#ifdef NO_G4
#define GC4 if (0)
#else
#define GC4
#endif
#ifndef REP_MIX
#define REP_MIX 1
#endif
#ifndef REP_G1
#define REP_G1 1
#endif
#ifndef REP_UP
#define REP_UP 1
#endif
#ifndef MK_ONE_LAUNCH
#define MK_ONE_LAUNCH 1
#endif
constexpr int N_PHASES = 1 + 6 * DEPTH;
__global__ void __launch_bounds__(NTHREADS, 2) hymba_fwd(Params P) {
    extern __shared__ __attribute__((aligned(16))) unsigned char lds[];
    cg::grid_group grid = cg::this_grid();
    const int wv_k = __builtin_amdgcn_readfirstlane(threadIdx.x >> 6);
#define MYTID ({ int w__ = wv_k; asm volatile("" : "+s"(w__)); int l__ = (int)__builtin_amdgcn_mbcnt_hi(~0u, __builtin_amdgcn_mbcnt_lo(~0u, 0u)); asm volatile("" : "+v"(l__)); w__ * 64 + l__; })
#define LTID int tid = MYTID; asm volatile("" : "+v"(tid));
#define PTRS unsigned char* ws = P.ws; asm volatile("" : "+s"(ws)); unsigned* CTL = (unsigned*)(ws + WS_CTL); (void)CTL; \
    const float* PR = (const float*)(ws + WS_PAR); (void)PR; float* RP = (float*)(ws + WS_ROPE); (void)RP; float* SS = (float*)(ws + WS_SS); (void)SS; float* GATE = (float*)(ws + WS_GATE); (void)GATE; \
    bf16_t* XB = (bf16_t*)(ws + WS_XB); (void)XB; bf16_t* U = (bf16_t*)(ws + WS_U); (void)U; bf16_t* MIX = (bf16_t*)(ws + WS_MIX); (void)MIX; bf16_t* HB = (bf16_t*)(ws + WS_H); (void)HB; \
    unsigned char* wb = ws + WS_W + (size_t)l * W_LAYER; (void)wb;
    const int lo = P.ph_lo, hi = P.ph_hi;
#define IN(k) (lo <= (k) && (k) < hi)
    volatile LAS unsigned* bst = (volatile LAS unsigned*)((LAS unsigned char*)lds + LDS_BYTES - 32);
    if (threadIdx.x < 2) bst[threadIdx.x] = 0u;
    __syncthreads();
    XcdBarrier xbar = xcd_barrier_post((unsigned*)(P.ws + WS_CTL) + 1024, bst);
#define SEAM(k) do { if (IN(k) && IN((k) + 1)) { XcdBarrier xb2_ = xbar; asm volatile("" : "+s"(xb2_.bar)); xcd_barrier(xb2_, MYTID); } } while (0)
    if (P.ph_hi < 0) grid.sync();
#ifndef REP_P0
#define REP_P0 1
#endif
    if (IN(0)) { const int l = 0; PTRS for (int rep = 0; rep < REP_P0; ++rep) { p0_prep(P, lds, MYTID); { LTID row_prep(P.x, XB, SS, P.w_in, P.norm1_g, P.gate_b, GATE, (float*)lds, tid); } } }
    SEAM(0);
#ifdef PROBE_SYNC
    for (int i_ = 0; i_ < 10; ++i_) grid.sync();
#endif
#pragma unroll
    for (int l = 0; l < DEPTH; ++l) {
        const int pb = 1 + 6 * l;
        if (IN(pb + 0)) { PTRS
            if (l > 0) { LTID gates_prep(XB, SS + (2 * l) * M, (const float*)(ws + WS_WG) + l * 8 * D, PR + PAR_GB + l * 8, GATE, (float*)lds, tid); }
            pg8::Gemm g{XB, (const bf16_t*)(wb + W_IN), M, NU, D}; pg8::StaticOrder S; S.init(M, NU, gridDim.x, (int)blockIdx.x);
            pg8::EpiIn E{U, NU, SS + (2 * l) * M, RP, PR + PAR_QN + l * 64, PR + PAR_KN + l * 64};
            for (int rep = 0; rep < ((l == 0) ? REP_G1 : 1); ++rep)
            GC1 pg8::gemm_phase<pg8::EpiIn, pg8::StaticOrder, true, true>((PG8_LAS unsigned char*)lds, g, S, E, MYTID);
        }
        SEAM(pb + 0);
        if (IN(pb + 2)) { PTRS LTID
            volatile int* slot = (volatile int*)(lds + LDS_BYTES - 64);
            for (int rep = 0; rep < ((l == 0) ? REP_MIX : 1); ++rep)
            for (;;) {
                __syncthreads();
                if (tid == 0) *slot = (int)atomicAdd(CTL + 16 * l + rep, 1u);
                __syncthreads();
                const int id = *slot;
                if (id >= 128 + 1024) break;
                if (id < 64) {
#ifndef NO_ML
 mlstm_unit(U, GATE, MIX, PR + PAR_CW + l * 2048, PR + PAR_MN + l * 64, id >> 2, id & 3, lds, tid);
#endif
 }
                else if (id < 128) {
#ifndef NO_HG
 hgrn_unit(U, MIX, (const float*)(ws + WS_LB) + l * 256, PR + PAR_HN + l * 64, (id - 64) >> 2, (id - 64) & 3, lds, tid);
#endif
 }
                else {
#ifndef NO_AT
 const int a = id - 128; const int qb = 15 - (a >> 6), bh = a & 63;
                    int lsel = l; asm volatile("" : "+s"(lsel));
                    const float lam_init = (lsel == 0) ? 0.2f : 0.35550906759096926f;
                    const float lam = PR[PAR_LAMV + lsel];
                    attn_unit(U, MIX, bh >> 2, bh & 3, qb, lam, 1.f - lam_init, PR + PAR_SUB + l * 128, lds, tid);
#endif
 }
            }
        }
        SEAM(pb + 2);
        if (IN(pb + 3)) { PTRS
            pg8::Gemm g{MIX, (const bf16_t*)(wb + W_OUT), M, D, D}; pg8::StaticOrder S; S.init(M, D, gridDim.x, (int)blockIdx.x);
            pg8::EpiResidBf E{XB, P.out, D, SS + (2 * l + 1) * M, 0};
            GC2 pg8::gemm_phase<pg8::EpiResidBf, pg8::StaticOrder, true, true>((PG8_LAS unsigned char*)lds, g, S, E, MYTID);
        }
        SEAM(pb + 3);
        if (IN(pb + 4)) { PTRS
            pg8::Gemm g{XB, (const bf16_t*)(wb + W_UP), M, FF, D}; pg8::StaticOrder S; S.init(M, FF, gridDim.x, (int)blockIdx.x);
            pg8::EpiScaleBf16<1> E{HB, FF, SS + (2 * l + 1) * M};
            for (int rep = 0; rep < ((l == 0) ? REP_UP : 1); ++rep)
            GC3 pg8::gemm_phase<pg8::EpiScaleBf16<1>, pg8::StaticOrder, true, true>((PG8_LAS unsigned char*)lds, g, S, E, MYTID);
        }
        SEAM(pb + 4);
        if (IN(pb + 5)) { PTRS
            pg8::Gemm g{HB, (const bf16_t*)(wb + W_DN), M, D, FF}; pg8::StaticOrder S; S.init(M, D, gridDim.x, (int)blockIdx.x);
#ifdef PROBE_DN
            if (l == 0) { pg8::EpiScaleBf16<0> E2{XB, D, SS}; pg8::gemm_phase<pg8::EpiScaleBf16<0>, pg8::StaticOrder, true, true>((PG8_LAS unsigned char*)lds, g, S, E2, MYTID); }
#endif
            pg8::EpiResidBf E{XB, P.out, D, SS + ((2 * l + 2) & 3) * M, (l + 1 < DEPTH) ? 0 : 1};
            GC4 pg8::gemm_phase<pg8::EpiResidBf, pg8::StaticOrder, true, true>((PG8_LAS unsigned char*)lds, g, S, E, MYTID);
        }
        SEAM(pb + 5);
    }
#undef IN
#undef SEAM
}

extern "C" void kernel_launch(void* const* d_in, const int* in_sizes, int n_in, void* d_out, int out_size, void* d_ws, size_t ws_size, hipStream_t stream) {
    static int grid = 0;
    if (grid == 0) {
        if (n_in != 16 || in_sizes[0] != M * D || out_size != M * D || ws_size < WS_END) { fprintf(stderr, "kernel_launch: unexpected shapes (n_in %d in0 %d out %d ws %zu)\n", n_in, n_in > 0 ? in_sizes[0] : -1, out_size, ws_size); grid = -1; return; }
        int dev = 0, cus = 0, per_cu = 0;
        hipGetDevice(&dev); hipDeviceGetAttribute(&cus, hipDeviceAttributeMultiprocessorCount, dev);
        if (hipFuncSetAttribute((const void*)hymba_fwd, hipFuncAttributeMaxDynamicSharedMemorySize, LDS_BYTES) != hipSuccess) { fprintf(stderr, "kernel_launch: hipFuncSetAttribute failed\n"); grid = -1; return; }
        if (hipOccupancyMaxActiveBlocksPerMultiprocessor(&per_cu, (const void*)hymba_fwd, NTHREADS, LDS_BYTES) != hipSuccess || per_cu < 1) { fprintf(stderr, "kernel_launch: occupancy query gave %d\n", per_cu); per_cu = 1; }
        (void)hipGetLastError();
        grid = cus * per_cu;
        fprintf(stderr, "kernel_launch: grid %d (%d CUs x %d)\n", grid, cus, per_cu);
    }
    if (grid < 0) return;
    hipMemsetAsync((char*)d_ws + WS_CTL, 0, CTL_BYTES, stream);
    Params p{};
    p.x = (const float*)d_in[0]; p.norm1_g = (const float*)d_in[1]; p.w_in = (const float*)d_in[2]; p.conv_w = (const float*)d_in[3]; p.gate_b = (const float*)d_in[4]; p.mnorm_g = (const float*)d_in[5];
    p.qn_g = (const float*)d_in[6]; p.kn_g = (const float*)d_in[7]; p.lam = (const float*)d_in[8]; p.subln_g = (const float*)d_in[9]; p.lb_param = (const float*)d_in[10]; p.hnorm_g = (const float*)d_in[11];
    p.w_out = (const float*)d_in[12]; p.norm2_g = (const float*)d_in[13]; p.w_up = (const float*)d_in[14]; p.w_down = (const float*)d_in[15];
    p.out = (float*)d_out; p.ws = (unsigned char*)d_ws;
#if MK_ONE_LAUNCH
    p.ph_lo = 0; p.ph_hi = N_PHASES;
    void* args[] = {&p};
    hipError_t e = hipLaunchCooperativeKernel((const void*)hymba_fwd, dim3(grid), dim3(NTHREADS), args, LDS_BYTES, stream);
    if (e != hipSuccess) fprintf(stderr, "cooperative launch failed: %s (grid %d)\n", hipGetErrorString(e), grid);
#else
    for (int ph = 0; ph < N_PHASES; ++ph) { p.ph_lo = ph; p.ph_hi = ph + 1; hipLaunchKernelGGL(hymba_fwd, dim3(grid), dim3(NTHREADS), LDS_BYTES, stream, p); }
#endif
}
```
